# Optimizing an MI355X kernel written in HIP

```python
import math
import jax
import jax.numpy as jnp
from jax import lax
import numpy as np

D_MODEL = 1024
BATCH = 8
SEQ = 8192
DEPTH = 1
DEC_BATCH = 8
DEC_SEQ = 32
PAST_LEN = 4096

CHUNK = 64
N_HEADS_A = 8
HEAD_DIM_A = 64
N_HEADS_IDX = 4
HEAD_DIM_IDX = 64
TOPK_MAX = 256
Q_BLOCK = CHUNK
NUM_BUCKETS = 32
MAX_DISTANCE = 1024
N_HEADS_R = 8
KEY_DIM_R = 64
VAL_DIM_R = 128
ROPE_BASE = 10000.0
D_FF = -(-8 * D_MODEL // (3 * 256)) * 256
ALPHA = (2.0 * DEPTH) ** 0.25
BETA = (8.0 * DEPTH) ** -0.25
LN_EPS = 1e-5
GN_EPS = 1e-6
W_A = N_HEADS_A * HEAD_DIM_A
W_IQ = N_HEADS_IDX * HEAD_DIM_IDX
W_RQK = N_HEADS_R * KEY_DIM_R
W_RV = N_HEADS_R * VAL_DIM_R
SPLIT_SIZES = (W_A, W_A, W_A, W_IQ, HEAD_DIM_IDX, N_HEADS_IDX, W_RQK, W_RQK, W_RV, W_RV, D_MODEL, D_MODEL)
D_IN = sum(SPLIT_SIZES)

kernel_name = 'dsa_retention_streaming_encoder'


def layer_norm(x, g, b, eps=LN_EPS):
    xf = x.astype(jnp.float32)
    mu = jnp.mean(xf, axis=-1, keepdims=True)
    var = jnp.mean(jnp.square(xf - mu), axis=-1, keepdims=True)
    y = (xf - mu) * lax.rsqrt(var + eps) * g.astype(jnp.float32) + b.astype(jnp.float32)
    return y.astype(x.dtype)


def project(x, w_in):
    h = jnp.einsum('btd,de->bte', x, w_in)
    offsets = tuple(int(v) for v in np.cumsum(SPLIT_SIZES)[:-1])
    return jnp.split(h, offsets, axis=-1)


def rotary(x, pos):
    half = x.shape[-1] // 2
    inv_freq = ROPE_BASE ** (-jnp.arange(half, dtype=jnp.float32) / half)
    ang = pos.astype(jnp.float32)[:, None] * inv_freq[None, :]
    cos = jnp.cos(ang)[None, :, None, :]
    sin = jnp.sin(ang)[None, :, None, :]
    xf = x.astype(jnp.float32)
    x1, x2 = xf[..., :half], xf[..., half:]
    return jnp.concatenate([x1 * cos - x2 * sin, x1 * sin + x2 * cos], axis=-1).astype(x.dtype)


def t5_bucket(rel):
    nb = NUM_BUCKETS // 2
    max_exact = nb // 2
    ret = jnp.where(rel > 0, nb, 0)
    n = jnp.abs(rel)
    nf = jnp.maximum(n, max_exact).astype(jnp.float32)
    large = max_exact + (jnp.log(nf / max_exact) / math.log(MAX_DISTANCE / max_exact) * (nb - max_exact)).astype(jnp.int32)
    large = jnp.minimum(large, nb - 1)
    return ret + jnp.where(n < max_exact, n, large)


def dsa_attend(q, qi, w_idx, qpos, k, v, k_idx, t5_bias, n_top):
    L = k.shape[1]
    kpos = jnp.arange(L, dtype=jnp.int32)
    rel = jax.nn.relu(jnp.einsum('bqhd,bsd->bqhs', qi, k_idx) * (HEAD_DIM_IDX ** -0.5))
    score = jnp.einsum('bqhs,bqh->bqs', rel, w_idx).astype(jnp.float32)
    admissible = (kpos[None, :] // CHUNK) <= (qpos[:, None] // CHUNK)
    score = jnp.where(admissible[None], score, -jnp.inf)
    top, idx = lax.top_k(score, n_top)
    valid = jnp.isfinite(top)
    gather = jax.vmap(lambda a, i: a[i])
    k_sel = gather(k, idx)
    v_sel = gather(v, idx)
    bias = t5_bias[t5_bucket(idx - qpos[None, :, None])]
    logits = jnp.einsum('bqhd,bqnhd->bqhn', q, k_sel).astype(jnp.float32) * (HEAD_DIM_A ** -0.5)
    logits = logits + jnp.moveaxis(bias, 3, 2).astype(jnp.float32)
    logits = jnp.where(valid[:, :, None, :], logits, -jnp.inf)
    p = jax.nn.softmax(logits, axis=-1).astype(v.dtype)
    return jnp.einsum('bqhn,bqnhd->bqhd', p, v_sel)


def retention_chunk(q, k, v, S, log_gamma):
    C = q.shape[2]
    n = jnp.arange(C, dtype=jnp.float32)
    diff = n[:, None] - n[None, :]
    lg = log_gamma[:, None, None]
    D = jnp.where(diff >= 0, jnp.exp(lg * jnp.maximum(diff, 0.0)), 0.0)
    qf, kf, vf = q.astype(jnp.float32), k.astype(jnp.float32), v.astype(jnp.float32)
    inner = jnp.einsum('bhnd,bhmd->bhnm', qf, kf) * D[None]
    q_dec = qf * jnp.exp(log_gamma[:, None] * (n + 1.0))[None, :, :, None]
    o = jnp.einsum('bhnm,bhme->bhne', inner, vf) + jnp.einsum('bhnd,bhde->bhne', q_dec, S)
    k_dec = kf * jnp.exp(log_gamma[:, None] * (C - 1.0 - n))[None, :, :, None]
    S_new = jnp.exp(log_gamma * C)[None, :, None, None] * S + jnp.einsum('bhmd,bhme->bhde', k_dec, vf)
    return o, S_new


def retention_output(o, gate, gn_g):
    B, H, T, dv = o.shape
    mu = jnp.mean(o, axis=-1, keepdims=True)
    var = jnp.mean(jnp.square(o - mu), axis=-1, keepdims=True)
    on = (o - mu) * lax.rsqrt(var + GN_EPS)
    on = on.transpose(0, 2, 1, 3).reshape(B, T, H * dv) * gn_g.astype(jnp.float32)
    return on.astype(gate.dtype) * jax.nn.silu(gate)


def split_inputs(x, pos, w_in, idx_g, idx_b):
    B, T, _ = x.shape
    qa, ka, va, qi, ki, wi, qr, kr, vr, gr, g_a, g_r = project(x, w_in)
    qa = qa.reshape(B, T, N_HEADS_A, HEAD_DIM_A)
    ka = ka.reshape(B, T, N_HEADS_A, HEAD_DIM_A)
    va = va.reshape(B, T, N_HEADS_A, HEAD_DIM_A)
    qi = qi.reshape(B, T, N_HEADS_IDX, HEAD_DIM_IDX)
    ki = layer_norm(ki, idx_g, idx_b)
    wi = wi * (N_HEADS_IDX ** -0.5)
    qr = rotary(qr.reshape(B, T, N_HEADS_R, KEY_DIM_R), pos).transpose(0, 2, 1, 3)
    kr = (rotary(kr.reshape(B, T, N_HEADS_R, KEY_DIM_R), pos) * (KEY_DIM_R ** -0.5)).transpose(0, 2, 1, 3)
    vr = vr.reshape(B, T, N_HEADS_R, VAL_DIM_R).transpose(0, 2, 1, 3)
    return qa, ka, va, qi, ki, wi, qr, kr, vr, gr, g_a, g_r


def finish_layer(x, a, o_ret, gr, g_a, g_r, ret_gn_g, w_pa, w_pr, w_o, ln1_g, ln1_b, w_gate, w_up, w_down, ln2_g, ln2_b):
    r = retention_output(o_ret, gr, ret_gn_g)
    merged = jax.nn.sigmoid(g_a) * (a @ w_pa) + jax.nn.sigmoid(g_r) * (r @ w_pr)
    x1 = layer_norm(ALPHA * x + merged @ w_o, ln1_g, ln1_b)
    h = jax.nn.silu(x1 @ w_gate) * (x1 @ w_up)
    return layer_norm(ALPHA * x1 + h @ w_down, ln2_g, ln2_b)


def prompt_sparse_attention(qa, ka, va, qi, ki, wi, t5_bias):
    B, T = qa.shape[:2]
    nb = T // Q_BLOCK
    n_top = min(TOPK_MAX, T // 4)

    def blockify(a):
        return jnp.moveaxis(a.reshape((B, nb, Q_BLOCK) + a.shape[2:]), 1, 0)

    qpos = jnp.arange(T, dtype=jnp.int32).reshape(nb, Q_BLOCK)

    def one_block(xs):
        q_b, qi_b, w_b, pos_b = xs
        return dsa_attend(q_b, qi_b, w_b, pos_b, ka, va, ki, t5_bias, n_top)

    out = lax.map(one_block, (blockify(qa), blockify(qi), blockify(wi), qpos))
    return jnp.moveaxis(out, 0, 1).reshape(B, T, W_A)


def prompt_retention(qr, kr, vr, log_gamma):
    B, H, T, _ = qr.shape
    nc = T // CHUNK

    def chunkify(a):
        return jnp.moveaxis(a.reshape(B, H, nc, CHUNK, a.shape[-1]), 2, 0)

    def step(S, xs):
        q_c, k_c, v_c = xs
        o_c, S_new = retention_chunk(q_c, k_c, v_c, S, log_gamma)
        return S_new, o_c

    S0 = jnp.zeros((B, H, KEY_DIM_R, VAL_DIM_R), jnp.float32)
    S_fin, o = lax.scan(step, S0, (chunkify(qr), chunkify(kr), chunkify(vr)))
    o = jnp.moveaxis(o, 0, 2).reshape(B, H, T, VAL_DIM_R)
    return o, S_fin


def setup_inputs(seed: int = 0) -> dict:
    key = jax.random.key(seed)
    ks = jax.random.split(key, 24)
    nrm = jax.random.normal
    f32 = jnp.float32
    return {
        'x_prompt': nrm(ks[0], (BATCH, SEQ, D_MODEL), f32),
        'x_sample': nrm(ks[1], (DEC_BATCH, DEC_SEQ, D_MODEL), f32),
        'cache_k': nrm(ks[2], (DEPTH, DEC_BATCH, PAST_LEN, N_HEADS_A, HEAD_DIM_A), f32),
        'cache_v': nrm(ks[3], (DEPTH, DEC_BATCH, PAST_LEN, N_HEADS_A, HEAD_DIM_A), f32),
        'cache_idx_k': nrm(ks[4], (DEPTH, DEC_BATCH, PAST_LEN, HEAD_DIM_IDX), f32),
        'state_ret': 0.5 * nrm(ks[5], (DEPTH, DEC_BATCH, N_HEADS_R, KEY_DIM_R, VAL_DIM_R), f32),
        'w_in': nrm(ks[6], (DEPTH, D_MODEL, D_IN), f32) * D_MODEL ** -0.5,
        'idx_k_norm_g': 1.0 + 0.02 * nrm(ks[7], (DEPTH, HEAD_DIM_IDX), f32),
        'idx_k_norm_b': 0.02 * nrm(ks[8], (DEPTH, HEAD_DIM_IDX), f32),
        't5_bias': 0.5 * nrm(ks[9], (NUM_BUCKETS, N_HEADS_A), f32),
        'ret_gn_g': 1.0 + 0.02 * nrm(ks[10], (DEPTH, W_RV), f32),
        'w_pa': nrm(ks[11], (DEPTH, W_A, D_MODEL), f32) * W_A ** -0.5,
        'w_pr': nrm(ks[12], (DEPTH, W_RV, D_MODEL), f32) * W_RV ** -0.5,
        'w_o': nrm(ks[13], (DEPTH, D_MODEL, D_MODEL), f32) * (D_MODEL ** -0.5 * BETA),
        'ln1_g': 1.0 + 0.02 * nrm(ks[14], (DEPTH, D_MODEL), f32),
        'ln1_b': 0.02 * nrm(ks[15], (DEPTH, D_MODEL), f32),
        'w_gate': nrm(ks[16], (DEPTH, D_MODEL, D_FF), f32) * D_MODEL ** -0.5,
        'w_up': nrm(ks[17], (DEPTH, D_MODEL, D_FF), f32) * D_MODEL ** -0.5,
        'w_down': nrm(ks[18], (DEPTH, D_FF, D_MODEL), f32) * (D_FF ** -0.5 * BETA),
        'ln2_g': 1.0 + 0.02 * nrm(ks[19], (DEPTH, D_MODEL), f32),
        'ln2_b': 0.02 * nrm(ks[20], (DEPTH, D_MODEL), f32),
    }


def reference(x_prompt, x_sample, cache_k, cache_v, cache_idx_k, state_ret, w_in, idx_k_norm_g, idx_k_norm_b,
              t5_bias, ret_gn_g, w_pa, w_pr, w_o, ln1_g, ln1_b, w_gate, w_up, w_down, ln2_g, ln2_b):
    log_gamma = jnp.log1p(-jnp.exp2(-5.0 - jnp.arange(N_HEADS_R, dtype=jnp.float32)))
    yp, ys = x_prompt, x_sample
    kp_l, vp_l, ikp_l, sp_l = [], [], [], []
    ks_l, vs_l, iks_l, ss_l = [], [], [], []
    for l in range(DEPTH):
        lw = (ret_gn_g[l], w_pa[l], w_pr[l], w_o[l], ln1_g[l], ln1_b[l], w_gate[l], w_up[l], w_down[l], ln2_g[l], ln2_b[l])

        T = yp.shape[1]
        pos_p = jnp.arange(T, dtype=jnp.int32)
        qa, ka, va, qi, ki, wi, qr, kr, vr, gr, g_a, g_r = split_inputs(yp, pos_p, w_in[l], idx_k_norm_g[l], idx_k_norm_b[l])
        a_p = prompt_sparse_attention(qa, ka, va, qi, ki, wi, t5_bias)
        o_p, s_p = prompt_retention(qr, kr, vr, log_gamma)
        yp_new = finish_layer(yp, a_p, o_p, gr, g_a, g_r, *lw)
        kp_l.append(ka)
        vp_l.append(va)
        ikp_l.append(ki)
        sp_l.append(s_p)

        past = cache_k.shape[2]
        Bs, Ts = ys.shape[:2]
        pos_s = past + jnp.arange(Ts, dtype=jnp.int32)
        qa_s, ka_s, va_s, qi_s, ki_s, wi_s, qr_s, kr_s, vr_s, gr_s, g_a_s, g_r_s = split_inputs(
            ys, pos_s, w_in[l], idx_k_norm_g[l], idx_k_norm_b[l])
        k_all = jnp.concatenate([cache_k[l], ka_s.astype(cache_k.dtype)], axis=1)
        v_all = jnp.concatenate([cache_v[l], va_s.astype(cache_v.dtype)], axis=1)
        ki_all = jnp.concatenate([cache_idx_k[l], ki_s.astype(cache_idx_k.dtype)], axis=1)
        L = past + Ts
        a_s = dsa_attend(qa_s, qi_s, wi_s, pos_s, k_all, v_all, ki_all, t5_bias, min(TOPK_MAX, L // 4)).reshape(Bs, Ts, W_A)
        o_s, s_s = retention_chunk(qr_s, kr_s, vr_s, state_ret[l].astype(jnp.float32), log_gamma)
        ys_new = finish_layer(ys, a_s, o_s, gr_s, g_a_s, g_r_s, *lw)
        ks_l.append(ka_s)
        vs_l.append(va_s)
        iks_l.append(ki_s)
        ss_l.append(s_s.astype(state_ret.dtype))

        yp, ys = yp_new, ys_new

    return (yp, ys,
            jnp.stack(kp_l), jnp.stack(vp_l), jnp.stack(ikp_l), jnp.stack(sp_l),
            jnp.stack(ks_l), jnp.stack(vs_l), jnp.stack(iks_l), jnp.stack(ss_l))
```

```cpp
#include <hip/hip_runtime.h>
#include <hip/hip_cooperative_groups.h>
#include <cstdio>
namespace cg = cooperative_groups;

typedef unsigned short u16;
using bf16x8 = __attribute__((ext_vector_type(8))) short;
using bf16x4 = __attribute__((ext_vector_type(4))) short;
using f32x4 = __attribute__((ext_vector_type(4))) float;
using f32x16 = __attribute__((ext_vector_type(16))) float;
typedef __bf16 bfv2 __attribute__((ext_vector_type(2)));
typedef float fv2 __attribute__((ext_vector_type(2)));
#define DI __device__ __forceinline__

constexpr int NTP = 65536, NTS = 256, MTOK = 65792, DM = 1024, DINSRC = 6980, NF = 7168, DFF = 2816;
constexpr int F_KA = 512, F_VA = 1024, F_QI = 1536, F_KI = 1792, F_WI = 1856, F_QR = 1920, F_KR = 2432, F_VR = 2944,
              F_GR = 3968, F_GA = 4992, F_GRR = 6016, F_END = 7040;
constexpr long O_Y = 0, O_KP = 67371008L, O_VP = O_KP + 33554432L, O_IKP = O_VP + 33554432L, O_SP = O_IKP + 4194304L,
               O_KS = O_SP + 524288L, O_VS = O_KS + 131072L, O_IKS = O_VS + 131072L, O_SS = O_IKS + 16384L;
constexpr long OB_XB = 0, OB_VAT = 134742016L, OB_SVT = OB_VAT + 67108864L;
constexpr long W_WIN = 0;
constexpr long W_WPA = W_WIN + 14680064L;
constexpr long W_WPR = W_WPA + 1048576L;
constexpr long W_WO = W_WPR + 2097152L;
constexpr long W_WGU = W_WO + 2097152L;
constexpr long W_WDN = W_WGU + 11534336L;
constexpr long W_ROT = W_WDN + 5767168L;
constexpr long W_T5 = W_ROT + 2097152L;
constexpr long W_CTR = W_T5 + 43008L;
constexpr long R_QA = W_CTR + 256L;
constexpr long R_GR = R_QA + 67371008L;
constexpr long R_GA = R_GR + 134742016L;
constexpr long R_GRR = R_GA + 134742016L;
constexpr long R_KA = R_GRR + 134742016L;
constexpr long R_SK = R_KA + 67108864L;
constexpr long R_QI = R_SK + 34078720L;
constexpr long R_KI = R_QI + 33685504L;
constexpr long R_SKI = R_KI + 8388608L;
constexpr long R_WI = R_SKI + 4259840L;
constexpr long R_QR = R_WI + 1052672L;
constexpr long R_KR = R_QR + 67371008L;
constexpr long R_KRT = R_KR + 67371008L;
constexpr long R_SKRT = R_KRT + 67108864L;
constexpr long R_VRT = R_SKRT + 262144L;
constexpr long R_SVRT = R_VRT + 134217728L;
constexpr long R_END = R_SVRT + 524288L;
constexpr long R_MERGED = R_QR;
constexpr long R_TB = R_GR;
constexpr long R_T2B = R_QR;
constexpr long R_X1 = R_KRT;
constexpr long R_HMID = R_QA;
constexpr int T5N = 1344, T5OFF = 1277;
constexpr int LDS_BYTES = 147456;
constexpr float ALPHA = 1.189207115002721f;
constexpr float LOG2E = 1.4426950408889634f;
constexpr float QSCALE = 0.125f * LOG2E;

struct Params {
  const float *x_p, *x_s, *cache_k, *cache_v, *cache_ik, *state, *w_in, *ikg, *ikb, *t5, *gng, *w_pa, *w_pr, *w_o, *ln1g,
      *ln1b, *w_gate, *w_up, *w_down, *ln2g, *ln2b;
  float* out;
  unsigned char* ws;
  int ph_lo, ph_hi;
};

DI unsigned pack2(float a, float b) {
  fv2 v = {a, b};
  bfv2 r = __builtin_convertvector(v, bfv2);
  return __builtin_bit_cast(unsigned, r);
}
DI u16 f2bf(float a) { return (u16)(pack2(a, 0.f) & 0xffffu); }
DI float bf2f(u16 b) { return __uint_as_float(((unsigned)b) << 16); }
DI float bflo(unsigned u) { return __uint_as_float(u << 16); }
DI float bfhi(unsigned u) { return __uint_as_float(u & 0xffff0000u); }
DI uint2 pack4(float a, float b, float c, float d) { return make_uint2(pack2(a, b), pack2(c, d)); }
DI float log_gamma_h(int h) { return log1pf(-exp2f(-5.0f - (float)h)); }
DI float sigmoidf_(float x) { return 1.0f / (1.0f + __expf(-x)); }
DI float siluf_(float x) { return x / (1.0f + __expf(-x)); }
DI int crow(int r, int g) { return (r & 3) + 8 * (r >> 2) + 4 * g; }
#define MFMA32(a, b, c) __builtin_amdgcn_mfma_f32_32x32x16_bf16((a), (b), (c), 0, 0, 0)
DI bf16x8 ld16(const u16* p) { return *reinterpret_cast<const bf16x8*>(p); }
DI bf16x8 ld8x2(const u16* p0, const u16* p1) {
  bf16x4 a = *reinterpret_cast<const bf16x4*>(p0);
  bf16x4 b = *reinterpret_cast<const bf16x4*>(p1);
  bf16x8 r;
  r[0] = a[0]; r[1] = a[1]; r[2] = a[2]; r[3] = a[3]; r[4] = b[0]; r[5] = b[1]; r[6] = b[2]; r[7] = b[3];
  return r;
}
DI bf16x8 packacc8(const f32x16& x, int s) {
  unsigned p0 = pack2(x[8 * s + 0], x[8 * s + 1]), p1 = pack2(x[8 * s + 2], x[8 * s + 3]);
  unsigned p2 = pack2(x[8 * s + 4], x[8 * s + 5]), p3 = pack2(x[8 * s + 6], x[8 * s + 7]);
  uint4 u = make_uint4(p0, p1, p2, p3);
  return __builtin_bit_cast(bf16x8, u);
}

constexpr int BK = 64, HALF = 128, HT = HALF * BK;
DI int lds_byte(int r, int c) {
  int st = (r >> 4) * 2 + (c >> 5), rr = r & 15, cc = c & 31, ob = rr * 64 + cc * 2;
  return st * 1024 + (ob ^ (((ob >> 9) & 1) << 5));
}
DI void stage_rc(int b, int& R, int& C) {
  int st = b / 1024, sb = b % 1024, swz = sb ^ (((sb >> 9) & 1) << 5);
  R = (st >> 1) * 16 + swz / 64;
  C = (st & 1) * 32 + (swz % 64) / 2;
}

typedef f32x4 acc_t[2][2][4][2];

DI void gemm_core(acc_t& acc, const u16* __restrict__ A, long lda, const u16* __restrict__ Bt, long ldb, int K, int brow,
                  int bcol, u16* shm) {
#define SA(b, h) (shm + ((b)*2 + (h)) * HT)
#define SB(b, h) (shm + (4 + (b)*2 + (h)) * HT)
#define STAGE(P, BASE, LD, br, kt)                                                                            \
  do {                                                                                                        \
    long _g = (long)(br) * (LD) + (long)(kt)*BK;                                                              \
    __builtin_amdgcn_global_load_lds((const unsigned*)((BASE) + _g + (long)sr0 * (LD) + sc0),                 \
                                     (unsigned*)((char*)(P) + sb0), 16, 0, 0);                                \
    __builtin_amdgcn_global_load_lds((const unsigned*)((BASE) + _g + (long)sr1 * (LD) + sc1),                 \
                                     (unsigned*)((char*)(P) + sb0 + 8192), 16, 0, 0);                         \
  } while (0)
#define LDA(dst, b, h)                                                                                        \
  for (int m = 0; m < 4; ++m)                                                                                 \
    for (int k = 0; k < 2; ++k)                                                                               \
      dst[m][k] = *reinterpret_cast<const bf16x8*>((char*)SA(b, h) + lds_byte(wr * 64 + m * 16 + fr, k * 32 + fq * 8))
#define LDB(dst, b, h)                                                                                        \
  for (int n = 0; n < 2; ++n)                                                                                 \
    for (int k = 0; k < 2; ++k)                                                                               \
      dst[n][k] = *reinterpret_cast<const bf16x8*>((char*)SB(b, h) + lds_byte(wc * 32 + n * 16 + fr, k * 32 + fq * 8))
#define MMA(ai, bj, At_, Bt_)                                                                                 \
  do {                                                                                                        \
    __builtin_amdgcn_s_setprio(1);                                                                            \
    for (int m = 0; m < 4; ++m)                                                                               \
      for (int n = 0; n < 2; ++n)                                                                             \
        for (int k = 0; k < 2; ++k)                                                                           \
          acc[ai][bj][m][n] = __builtin_amdgcn_mfma_f32_16x16x32_bf16(At_[m][k], Bt_[n][k], acc[ai][bj][m][n], 0, 0, 0); \
    __builtin_amdgcn_s_setprio(0);                                                                            \
  } while (0)
#define WAIT_V(n) asm volatile("s_waitcnt vmcnt(" #n ")" ::: "memory")
#define WAIT_L(n) asm volatile("s_waitcnt lgkmcnt(" #n ")" ::: "memory")
#define BAR __builtin_amdgcn_s_barrier()
#define SCHED __builtin_amdgcn_sched_barrier(0)
  int tidg = threadIdx.x;
  asm volatile("" : "+v"(tidg));
  const int wid = tidg >> 6, lane = tidg & 63, wr = __builtin_amdgcn_readfirstlane(wid >> 2), wc = wid & 3, fr = lane & 15, fq = lane >> 4;
  const int sb0 = tidg * 16;
  int sr0, sc0, sr1, sc1;
  stage_rc(sb0, sr0, sc0);
  stage_rc(sb0 + 8192, sr1, sc1);
  bf16x8 At[4][2], B0[2][2], B1[2][2];
  const int nt = K / BK;
  STAGE(SB(0, 0), Bt, ldb, bcol, 0); STAGE(SA(0, 0), A, lda, brow, 0);
  STAGE(SB(0, 1), Bt, ldb, bcol + HALF, 0); STAGE(SA(0, 1), A, lda, brow + HALF, 0);
  if (wr == 1) BAR;
  WAIT_V(4); BAR;
  STAGE(SB(1, 0), Bt, ldb, bcol, 1); STAGE(SA(1, 0), A, lda, brow, 1); STAGE(SB(1, 1), Bt, ldb, bcol + HALF, 1);
  WAIT_V(6); BAR;
#pragma unroll 1
  for (int t = 0; t < nt - 2; t += 2) {
    LDB(B0, 0, 0); SCHED; LDA(At, 0, 0); STAGE(SA(1, 1), A, lda, brow + HALF, t + 1);
    WAIT_L(8); BAR; WAIT_L(0); MMA(0, 0, At, B0); BAR; SCHED;
    LDB(B1, 0, 1); STAGE(SB(0, 0), Bt, ldb, bcol, t + 2);
    BAR; WAIT_L(0); MMA(0, 1, At, B1); BAR;
    LDA(At, 0, 1); STAGE(SA(0, 0), A, lda, brow, t + 2);
    BAR; WAIT_L(0); MMA(1, 0, At, B0); BAR; SCHED;
    STAGE(SB(0, 1), Bt, ldb, bcol + HALF, t + 2);
    WAIT_V(6); BAR; MMA(1, 1, At, B1); BAR;
    LDB(B0, 1, 0); SCHED; LDA(At, 1, 0); STAGE(SA(0, 1), A, lda, brow + HALF, t + 2);
    WAIT_L(8); BAR; WAIT_L(0); MMA(0, 0, At, B0); BAR; SCHED;
    LDB(B1, 1, 1); STAGE(SB(1, 0), Bt, ldb, bcol, t + 3);
    BAR; WAIT_L(0); MMA(0, 1, At, B1); BAR;
    LDA(At, 1, 1); STAGE(SA(1, 0), A, lda, brow, t + 3);
    BAR; WAIT_L(0); MMA(1, 0, At, B0); BAR; SCHED;
    STAGE(SB(1, 1), Bt, ldb, bcol + HALF, t + 3);
    WAIT_V(6); BAR; MMA(1, 1, At, B1); BAR;
  }
  { LDB(B0, 0, 0); LDA(At, 0, 0); STAGE(SA(1, 1), A, lda, brow + HALF, nt - 1);
    BAR; WAIT_L(0); MMA(0, 0, At, B0); BAR;
    LDB(B1, 0, 1); BAR; WAIT_L(0); MMA(0, 1, At, B1); BAR;
    LDA(At, 0, 1); WAIT_V(4); BAR; WAIT_L(0); MMA(1, 0, At, B0); MMA(1, 1, At, B1); BAR; }
  { LDB(B0, 1, 0); LDA(At, 1, 0); WAIT_V(2); BAR; WAIT_L(0); MMA(0, 0, At, B0); BAR;
    LDB(B1, 1, 1); WAIT_V(0); BAR; WAIT_L(0); MMA(0, 1, At, B1); BAR;
    LDA(At, 1, 1); BAR; WAIT_L(0); MMA(1, 0, At, B0); MMA(1, 1, At, B1); BAR; }
  if (wr == 0) BAR;
#undef SA
#undef SB
#undef STAGE
#undef LDA
#undef LDB
#undef MMA
}

DI void acc_zero(acc_t& acc) {
  for (int a = 0; a < 2; ++a) for (int b = 0; b < 2; ++b) for (int m = 0; m < 4; ++m) for (int n = 0; n < 2; ++n)
    acc[a][b][m][n] = f32x4{0.f, 0.f, 0.f, 0.f};
}

DI void unit_map(int u, int nft, int fpr, int& ttile, int& ftile) {
  const int main_units = 256 * nft;
  if (u < main_units) {
    const int tpg = 256 / fpr, upg = 256 * (nft / fpr);
    int g = u / upg, r = u % upg, round = r >> 8, w = r & 255, xcd = w & 7, slot = w >> 3, tpx = tpg >> 3;
    ttile = g * tpg + xcd * tpx + (slot % tpx);
    ftile = round * fpr + slot / tpx;
  } else {
    ttile = 256;
    ftile = u - main_units;
  }
}

DI long kfrag_off(int key, int h, int d) {
  const int kb = key >> 5, kl = key & 31, ks = d >> 4, g = (d >> 3) & 1, e = d & 7;
  return ((((long)kb * 8 + h) * 4 + ks) * 64 + g * 32 + kl) * 8 + e;
}
DI long vfrag_off(int key, int h, int d) {
  const int kb = key >> 5, k5 = key & 31, sx = k5 >> 4, r = k5 & 15, g = (r >> 2) & 1, e = (r & 3) + 4 * (r >> 3);
  return ((((long)kb * 8 + h) * 4 + (sx * 2 + (d >> 5))) * 64 + g * 32 + (d & 31)) * 8 + e;
}
DI long kifrag_off(int key, int d) {
  const int kb = key >> 5, kl = key & 31, ks = d >> 4, g = (d >> 3) & 1, e = d & 7;
  return (((long)kb * 4 + ks) * 64 + g * 32 + kl) * 8 + e;
}
template <int MODE>
DI void transpose_tile(const float* __restrict__ src, const float* __restrict__ src2, long lds_, u16* __restrict__ dst,
                       long ldd, int k0, int n0, float* tile) {
  const int tid = threadIdx.x;
  __syncthreads();
  {
    int nn = tid & 63, n = (MODE == 3) ? nn : n0 + nn;
    const float* s = src;
    long col = n;
    bool ok = true;
    if (MODE == 1) {
      if (n < 1860) col = n; else if (n < F_QR) ok = false; else if (n < F_END) col = n - 60; else ok = false;
    } else if (MODE == 2) {
      int grp = n >> 6, within = n & 63;
      col = grp * 32 + (within & 31);
      s = (within < 32) ? src : src2;
    }
    for (int i = 0; i < 8; ++i) {
      int kk = (tid >> 6) + 8 * i;
      tile[kk * 65 + nn] = ok ? s[(long)(k0 + kk) * lds_ + col] : 0.f;
    }
  }
  __syncthreads();
  {
    int kk = tid & 63;
    for (int i = 0; i < 8; ++i) {
      int nn = (tid >> 6) + 8 * i;
      if (MODE == 3) dst[vfrag_off(k0 + kk, n0, nn)] = f2bf(tile[kk * 65 + nn]);
      else dst[(long)(n0 + nn) * ldd + k0 + kk] = f2bf(tile[kk * 65 + nn]);
    }
  }
}

DI void phase_prep(const Params& P, unsigned char* smem) {
  float* tile = (float*)smem;
  const int tid = threadIdx.x, nb = gridDim.x, bid = blockIdx.x;
  u16* xb = (u16*)((unsigned char*)P.out + OB_XB);
  for (long i = (long)bid * 512 + tid; i < (long)MTOK * DM / 8; i += (long)nb * 512) {
    long e = i * 8;
    const float* s = (e < (long)NTP * DM) ? (P.x_p + e) : (P.x_s + (e - (long)NTP * DM));
    float4 a = *(const float4*)s, b = *(const float4*)(s + 4);
    uint4 o = make_uint4(pack2(a.x, a.y), pack2(a.z, a.w), pack2(b.x, b.y), pack2(b.z, b.w));
    *(uint4*)(xb + e) = o;
  }
  {
    u16* sk = (u16*)(P.ws + R_SK);
    for (long i = (long)bid * 512 + tid; i < 8L * 4096 * 512 / 8; i += (long)nb * 512) {
      long e = i * 8;
      long b = e / (4096L * 512), r = e % (4096L * 512);
      const float* s = P.cache_k + e;
      float4 a = *(const float4*)s, c = *(const float4*)(s + 4);
      *(uint4*)(sk + b * 4160L * 512 + kfrag_off((int)(r >> 9), (int)((r >> 6) & 7), (int)(r & 63))) =
          make_uint4(pack2(a.x, a.y), pack2(a.z, a.w), pack2(c.x, c.y), pack2(c.z, c.w));
    }
    u16* ski = (u16*)(P.ws + R_SKI);
    for (long i = (long)bid * 512 + tid; i < 8L * 4096 * 64 / 8; i += (long)nb * 512) {
      long e = i * 8;
      long b = e / (4096L * 64), r = e % (4096L * 64);
      const float* s = P.cache_ik + e;
      float4 a = *(const float4*)s, c = *(const float4*)(s + 4);
      *(uint4*)(ski + b * 4160L * 64 + kifrag_off((int)(r >> 6), (int)(r & 63))) =
          make_uint4(pack2(a.x, a.y), pack2(a.z, a.w), pack2(c.x, c.y), pack2(c.z, c.w));
    }
  }
  {
    float2* rot = (float2*)(P.ws + W_ROT);
    for (int i = bid * 512 + tid; i < 8192 * 32; i += nb * 512) {
      int pos = i >> 5, fi = i & 31;
      float invf = powf(10000.0f, -(float)fi / 32.0f);
      float ang = (float)pos * invf;
      double a = (double)ang;
      double kq = rint(a * 0.15915494309189535);
      float r = (float)(a - kq * 6.283185307179586);
      rot[i] = make_float2(cosf(r), sinf(r));
    }
    float* t5t = (float*)(P.ws + W_T5);
    for (int i = bid * 512 + tid; i < 8 * T5N; i += nb * 512) {
      int h = i / T5N, idx = i % T5N, rel = idx - T5OFF;
      int n = rel < 0 ? -rel : rel;
      int bucket;
      if (n < 8) bucket = n;
      else {
        int lg = 8 + (int)(logf((float)n / 8.0f) / logf(128.0f) * 8.0f);
        bucket = lg < 15 ? lg : 15;
      }
      if (rel > 0) bucket += 16;
      t5t[i] = P.t5[bucket * 8 + h] * LOG2E;
    }
    if (bid == 0 && tid < 64) ((unsigned*)(P.ws + W_CTR))[tid] = 0u;
    {
      u16* svt = (u16*)((unsigned char*)P.out + OB_SVT);
      u16* sk = (u16*)(P.ws + R_SK);
      for (int i = bid * 512 + tid; i < 8 * 16384; i += nb * 512) {
        const long o = (long)(i >> 14) * 4160 * 512 + 129L * 16384 + (i & 16383);
        svt[o] = 0; sk[o] = 0;
      }
      u16* ski = (u16*)(P.ws + R_SKI);
      for (int i = bid * 512 + tid; i < 8 * 2048; i += nb * 512) ski[(long)(i >> 11) * 4160 * 64 + 129L * 2048 + (i & 2047)] = 0;
    }
  }
  const int T_WIN = (NF / 64) * 16, T_WPA = 16 * 8, T_WPR = 256, T_WO = 256, T_WGU = 88 * 16, T_WDN = 16 * 44, T_CV = 64 * 64;
  const int total = T_WIN + T_WPA + T_WPR + T_WO + T_WGU + T_WDN + T_CV;
  for (int j = bid; j < total; j += nb) {
    int q = j;
    if (q < T_WIN) { transpose_tile<1>(P.w_in, nullptr, DINSRC, (u16*)(P.ws + W_WIN), 1024, (q & 15) * 64, (q >> 4) * 64, tile); continue; }
    q -= T_WIN;
    if (q < T_WPA) { transpose_tile<0>(P.w_pa, nullptr, 1024, (u16*)(P.ws + W_WPA), 512, (q & 7) * 64, (q >> 3) * 64, tile); continue; }
    q -= T_WPA;
    if (q < T_WPR) { transpose_tile<0>(P.w_pr, nullptr, 1024, (u16*)(P.ws + W_WPR), 1024, (q & 15) * 64, (q >> 4) * 64, tile); continue; }
    q -= T_WPR;
    if (q < T_WO) { transpose_tile<0>(P.w_o, nullptr, 1024, (u16*)(P.ws + W_WO), 1024, (q & 15) * 64, (q >> 4) * 64, tile); continue; }
    q -= T_WO;
    if (q < T_WGU) { transpose_tile<2>(P.w_gate, P.w_up, DFF, (u16*)(P.ws + W_WGU), 1024, (q & 15) * 64, (q >> 4) * 64, tile); continue; }
    q -= T_WGU;
    if (q < T_WDN) { transpose_tile<0>(P.w_down, nullptr, 1024, (u16*)(P.ws + W_WDN), DFF, (q % 44) * 64, (q / 44) * 64, tile); continue; }
    q -= T_WDN;
    {
      int bh = q >> 6, tt = q & 63, b = bh >> 3, h = bh & 7;
      transpose_tile<3>(P.cache_v + (long)b * 4096 * 512 + h * 64, nullptr, 512,
                        (u16*)((unsigned char*)P.out + OB_SVT) + (long)b * 512 * 4160, 4160, tt * 64, h, tile);
    }
  }
}

DI int launder_tid() {
  int t = threadIdx.x;
  asm volatile("" : "+v"(t));
  return t;
}
constexpr int TLD = 68;
DI uint4 pk8(f32x4 a, f32x4 b) { return make_uint4(pack2(a[0], a[1]), pack2(a[2], a[3]), pack2(b[0], b[1]), pack2(b[2], b[3])); }

DI void epi_inproj(const Params& P, acc_t& acc, int ttile, int ftile, float* T) {
  const int tid_ = launder_tid();
  const int wid = tid_ >> 6, lane = tid_ & 63, wr = wid >> 2, wc = wid & 3, fr = lane & 15, fq = lane >> 4;
  const bool samp = (ttile == 256);
  unsigned char* ws = P.ws;
  float* out = P.out;
#pragma unroll
  for (int ai = 0; ai < 2; ++ai) {
    __syncthreads();
    {
      float* Tw = T + wr * (256 * TLD);
#pragma unroll
      for (int bj = 0; bj < 2; ++bj)
#pragma unroll
        for (int m = 0; m < 4; ++m)
#pragma unroll
          for (int n = 0; n < 2; ++n)
            *(f32x4*)(Tw + (bj * 128 + wc * 32 + n * 16 + fr) * TLD + m * 16 + fq * 4) = acc[ai][bj][m][n];
    }
    __syncthreads();
    const int grp = __builtin_amdgcn_readfirstlane(tid_ >> 8), tl = tid_ & 255;
    const int fg = ftile * 256 + ai * 128 + grp * 64;
    float* Tr = T + grp * (256 * TLD) + tl * TLD;
    const int tsub = tl >> 3, pj = tl & 7;
    const float* Tgp = T + grp * (256 * TLD) + 8 * pj;
    const long token = (long)ttile * 256 + tl;
    int b, t, pos, nn, C;
    if (!samp) { b = (int)(token >> 13); t = (int)(token & 8191); pos = t; nn = t & 63; C = 64; }
    else { b = tl >> 5; t = tl & 31; pos = 4096 + t; nn = t; C = 32; }
    int ttype = 0;
    if (fg < F_KA) {
      u16* o = (u16*)(ws + R_QA) + (long)ttile * 256 * 512 + fg + 8 * pj;
#pragma unroll 2
      for (int it = 0; it < 8; ++it) {
        const int tk = it * 32 + tsub;
        f32x4 a = *(const f32x4*)(Tgp + tk * TLD), c = *(const f32x4*)(Tgp + tk * TLD + 4);
        *(uint4*)(o + (long)tk * 512) = pk8(a * QSCALE, c * QSCALE);
      }
    } else if (fg < F_VA) {
      const int c0 = fg - F_KA, hh_ = c0 >> 6;
#pragma unroll 2
      for (int it = 0; it < 8; ++it) {
        const int tk = it * 32 + tsub;
        f32x4 a = *(const f32x4*)(Tgp + tk * TLD), c = *(const f32x4*)(Tgp + tk * TLD + 4);
        float* o; u16* kb; int keyi;
        if (!samp) {
          const long tok = (long)ttile * 256 + tk;
          o = out + O_KP + tok * 512 + c0 + 8 * pj;
          kb = (u16*)(ws + R_KA) + (tok >> 13) * (8192L * 512);
          keyi = (int)(tok & 8191);
        } else {
          o = out + O_KS + (long)tk * 512 + c0 + 8 * pj;
          kb = (u16*)(ws + R_SK) + (long)(tk >> 5) * 4160 * 512;
          keyi = 4096 + (tk & 31);
        }
        __builtin_nontemporal_store(a, (f32x4*)o); __builtin_nontemporal_store(c, (f32x4*)(o + 4));
        *(uint4*)(kb + kfrag_off(keyi, hh_, 8 * pj)) = pk8(a, c);
      }
    } else if (fg < F_QI) {
      const int c0 = fg - F_VA;
      float* o = (samp ? (out + O_VS) : (out + O_VP + (long)ttile * 256 * 512)) + c0 + 8 * pj;
#pragma unroll 2
      for (int it = 0; it < 8; ++it) {
        const int tk = it * 32 + tsub;
        __builtin_nontemporal_store(*(const f32x4*)(Tgp + tk * TLD), (f32x4*)(o + (long)tk * 512));
        __builtin_nontemporal_store(*(const f32x4*)(Tgp + tk * TLD + 4), (f32x4*)(o + (long)tk * 512 + 4));
      }
      ttype = 1;
    } else if (fg < F_KI) {
      u16* o = (u16*)(ws + R_QI) + (long)ttile * 256 * 256 + (fg - F_QI) + 8 * pj;
#pragma unroll 2
      for (int it = 0; it < 8; ++it) {
        const int tk = it * 32 + tsub;
        f32x4 a = *(const f32x4*)(Tgp + tk * TLD), c = *(const f32x4*)(Tgp + tk * TLD + 4);
        *(uint4*)(o + (long)tk * 256) = pk8(a, c);
      }
    } else if (fg == F_KI) {
      float s1 = 0.f;
      for (int k = 0; k < 16; ++k) { f32x4 a = *(const f32x4*)(Tr + 4 * k); s1 += a[0] + a[1] + a[2] + a[3]; }
      const float mean = s1 * (1.0f / 64.0f);
      float s2 = 0.f;
      for (int k = 0; k < 16; ++k) {
        f32x4 a = *(const f32x4*)(Tr + 4 * k);
        for (int j = 0; j < 4; ++j) { float d = a[j] - mean; s2 += d * d; }
      }
      const float rstd = rsqrtf(s2 * (1.0f / 64.0f) + 1e-5f);
      float* o = samp ? (out + O_IKS + (long)tl * 64) : (out + O_IKP + token * 64);
      u16* kb = samp ? ((u16*)(ws + R_SKI) + (long)b * 4160 * 64) : ((u16*)(ws + R_KI) + (long)b * 8192 * 64);
      const int keyi = samp ? 4096 + t : t;
#pragma unroll 2
      for (int k = 0; k < 8; ++k) {
        f32x4 a = *(const f32x4*)(Tr + 8 * k), c = *(const f32x4*)(Tr + 8 * k + 4);
        f32x4 g0 = *(const f32x4*)(P.ikg + 8 * k), g1 = *(const f32x4*)(P.ikg + 8 * k + 4);
        f32x4 b0 = *(const f32x4*)(P.ikb + 8 * k), b1 = *(const f32x4*)(P.ikb + 8 * k + 4);
        a = (a - mean) * rstd * g0 + b0;
        c = (c - mean) * rstd * g1 + b1;
        *(f32x4*)(o + 8 * k) = a; *(f32x4*)(o + 8 * k + 4) = c;
        *(uint4*)(kb + kifrag_off(keyi, 8 * k)) = pk8(a, c);
      }
    } else if (fg == F_WI) {
      f32x4 a = *(const f32x4*)Tr;
      *(f32x4*)((float*)(ws + R_WI) + token * 4) = a * 0.0625f;
    } else if (fg < F_VR) {
      const bool isk = fg >= F_KR;
      const int h = ((isk ? fg - F_KR : fg - F_QR)) >> 6;
      const float lg = log_gamma_h(h);
      const float dec = isk ? (expf(lg * (float)(C - 1 - nn)) * 0.125f) : expf(lg * (float)(nn + 1));
      const float* rot = (const float*)(ws + W_ROT) + ((long)pos * 32) * 2;
      u16* nat = (u16*)(ws + (isk ? R_KR : R_QR)) + token * 512 + h * 64;
#pragma unroll 2
      for (int k = 0; k < 4; ++k) {
        f32x4 xa = *(const f32x4*)(Tr + 8 * k), xb = *(const f32x4*)(Tr + 8 * k + 4);
        f32x4 ya = *(const f32x4*)(Tr + 32 + 8 * k), yb = *(const f32x4*)(Tr + 32 + 8 * k + 4);
        f32x4 r0 = *(const f32x4*)(rot + 16 * k), r1 = *(const f32x4*)(rot + 16 * k + 4);
        f32x4 r2 = *(const f32x4*)(rot + 16 * k + 8), r3 = *(const f32x4*)(rot + 16 * k + 12);
        f32x4 ca = {r0[0], r0[2], r1[0], r1[2]}, sa = {r0[1], r0[3], r1[1], r1[3]};
        f32x4 cb = {r2[0], r2[2], r3[0], r3[2]}, sb = {r2[1], r2[3], r3[1], r3[3]};
        f32x4 o1a = (xa * ca - ya * sa) * dec, o1b = (xb * cb - yb * sb) * dec;
        f32x4 o2a = (xa * sa + ya * ca) * dec, o2b = (xb * sb + yb * cb) * dec;
        *(uint4*)(nat + 8 * k) = pk8(o1a, o1b);
        *(uint4*)(nat + 32 + 8 * k) = pk8(o2a, o2b);
        if (isk) {
          *(f32x4*)(Tr + 8 * k) = o1a; *(f32x4*)(Tr + 8 * k + 4) = o1b;
          *(f32x4*)(Tr + 32 + 8 * k) = o2a; *(f32x4*)(Tr + 32 + 8 * k + 4) = o2b;
        }
      }
      if (isk) ttype = 2;
    } else if (fg < F_GR) {
      ttype = 3;
    } else if (fg < F_GA) {
      u16* o = (u16*)(ws + R_GR) + (long)ttile * 256 * 1024 + (fg - F_GR) + 8 * pj;
#pragma unroll 2
      for (int it = 0; it < 8; ++it) {
        const int tk = it * 32 + tsub;
        f32x4 a = *(const f32x4*)(Tgp + tk * TLD), c = *(const f32x4*)(Tgp + tk * TLD + 4);
        for (int j = 0; j < 4; ++j) { a[j] = siluf_(a[j]); c[j] = siluf_(c[j]); }
        *(uint4*)(o + (long)tk * 1024) = pk8(a, c);
      }
    } else if (fg < F_END) {
      const bool isr = fg >= F_GRR;
      u16* o = (u16*)(ws + (isr ? R_GRR : R_GA)) + (long)ttile * 256 * 1024 + (fg - (isr ? F_GRR : F_GA)) + 8 * pj;
#pragma unroll 2
      for (int it = 0; it < 8; ++it) {
        const int tk = it * 32 + tsub;
        f32x4 a = *(const f32x4*)(Tgp + tk * TLD), c = *(const f32x4*)(Tgp + tk * TLD + 4);
        for (int j = 0; j < 4; ++j) { a[j] = sigmoidf_(a[j]); c[j] = sigmoidf_(c[j]); }
        *(uint4*)(o + (long)tk * 1024) = pk8(a, c);
      }
    }
    __syncthreads();
    if (ttype != 0) {
      const int f = tl & 63, tb = tl >> 6;
      const float* Tg = T + grp * (256 * TLD) + f;
      u16* base;
      long ldt;
      int rowi;
      if (ttype == 1) { rowi = ((fg - F_VA) >> 6) * 64 + f; ldt = samp ? 4160 : 8192;
        base = samp ? ((u16*)((unsigned char*)out + OB_SVT) + 4096) : (u16*)((unsigned char*)out + OB_VAT); }
      else if (ttype == 2) { rowi = ((fg - F_KR) >> 6) * 64 + f; ldt = samp ? 32 : 8192;
        base = samp ? (u16*)(ws + R_SKRT) : (u16*)(ws + R_KRT); }
      else { rowi = (fg - F_VR) + f; ldt = samp ? 32 : 8192;
        base = samp ? (u16*)(ws + R_SVRT) : (u16*)(ws + R_VRT); }
      const int rows_per_b = (ttype == 3) ? 1024 : 512;
#pragma unroll 2
      for (int k = 0; k < 8; ++k) {
        const int t0l = tb * 64 + k * 8;
        int bb, tt0;
        if (!samp) { bb = ttile >> 5; tt0 = (ttile & 31) * 256 + t0l; }
        else { bb = t0l >> 5; tt0 = t0l & 31; }
        float x[8];
        for (int i2 = 0; i2 < 8; ++i2) x[i2] = Tg[(t0l + i2) * TLD];
        if (ttype == 1) {
          u16* vb = samp ? ((u16*)((unsigned char*)out + OB_SVT) + (long)bb * 512 * 4160) : ((u16*)((unsigned char*)out + OB_VAT) + (long)bb * 512 * 8192);
          const int keyi = samp ? 4096 + tt0 : tt0, hh_ = (fg - F_VA) >> 6;
          *(uint2*)(vb + vfrag_off(keyi, hh_, f)) = make_uint2(pack2(x[0], x[1]), pack2(x[2], x[3]));
          *(uint2*)(vb + vfrag_off(keyi + 4, hh_, f)) = make_uint2(pack2(x[4], x[5]), pack2(x[6], x[7]));
        } else
        *(uint4*)(base + ((long)bb * rows_per_b + rowi) * ldt + tt0) =
            make_uint4(pack2(x[0], x[1]), pack2(x[2], x[3]), pack2(x[4], x[5]), pack2(x[6], x[7]));
      }
    }
  }
}

DI void phase_inproj(const Params& P, unsigned char* smem) {
  const u16* W = (const u16*)(P.ws + W_WIN);
  const u16* X = (const u16*)((unsigned char*)P.out + OB_XB);
  const int nft = NF / 256, total = 257 * nft;
  for (int u = blockIdx.x; u < total; u += gridDim.x) {
    int tt, ft;
    unit_map(u, nft, 4, tt, ft);
    acc_t acc;
    acc_zero(acc);
    __syncthreads();
    gemm_core(acc, W, 1024, X, 1024, 1024, ft * 256, tt * 256, (u16*)smem);
    epi_inproj(P, acc, tt, ft, (float*)smem);
  }
}

constexpr int L_HIST = 0, L_RES = 65536, L_ITEM = L_RES + 1024, L_WV = L_ITEM + 64, L_CL = L_WV + 256, L_U = L_CL + 8 * 4096;
constexpr int L_T5 = L_U;
constexpr int L_LIST = L_U;
constexpr int CAND_CAP = 92;
static_assert(L_LIST + 8 * 8 * CAND_CAP * 8 <= LDS_BYTES && L_T5 + 8 * T5N * 4 <= LDS_BYTES, "LDS map");
constexpr int L_SBUF = 0, L_STAT = 36864, SLD = 72;

DI unsigned mono_key(float s) {
  unsigned u = __float_as_uint(s);
  return (u & 0x80000000u) ? ~u : (u | 0x80000000u);
}

DI int score_bin(float s, float isg) {
  const float a = fabsf(s) * isg;
  const int e = (int)(__float_as_uint(a) >> 18) - ((130 << 5) - 256);
  const int ec = (e + 192) >> 2;
  int k = e >= 64 ? e : ec;
  k = k < 0 ? 0 : (k > 254 ? 254 : k);
  return (s > 0.f) ? (256 + k) : ((s < 0.f) ? (254 - k) : 255);
}

DI void attn_item(const Params& P, unsigned char* smem, bool samp, int b, int c) {
  const int tid_ = launder_tid();
  const int wid = __builtin_amdgcn_readfirstlane(tid_ >> 6), lane = tid_ & 63, l32 = lane & 31, g = lane >> 5;
  unsigned char* ws = P.ws;
  asm volatile("" : "+s"(ws));
  const int nq = samp ? 32 : 64;
  const long qrow0 = samp ? (NTP + b * 32) : ((long)b * 8192 + c * 64);
  const int nkeys = samp ? 4128 : (c + 1) * 64;
  const int ntiles = (nkeys + 63) >> 6;
  const int qpos0 = samp ? 4096 : c * 64;
  const u16* Kb = samp ? ((const u16*)(ws + R_SK) + (long)b * 4160 * 512) : ((const u16*)(ws + R_KA) + (long)b * 8192 * 512);
  const u16* VTb = samp ? ((const u16*)((unsigned char*)P.out + OB_SVT) + (long)b * 512 * 4160)
                        : ((const u16*)((unsigned char*)P.out + OB_VAT) + (long)b * 512 * 8192);
  const long ldv = samp ? 4160 : 8192;
  const u16* KIb = samp ? ((const u16*)(ws + R_SKI) + (long)b * 4160 * 64) : ((const u16*)(ws + R_KI) + (long)b * 8192 * 64);
  unsigned* hist = (unsigned*)(smem + L_HIST) + wid * 2048;
  unsigned* maskl = (unsigned*)(smem + L_HIST);
  const float* t5l = (const float*)(smem + L_T5) + wid * T5N;
  int* resl = (int*)(smem + L_RES) + wid * 32;
  unsigned* cl = (unsigned*)(smem + L_CL) + wid * 1024;
  uint2* lst = (uint2*)(smem + L_LIST) + wid * (8 * CAND_CAP);
  unsigned* ccnt = (unsigned*)(smem + L_WV) + wid * 8;

  const bool all_sel = (nkeys <= 256);
  if (all_sel) {
    for (int i = lane; i < ntiles * 16; i += 64) {
      const int kt = i >> 4, r = i & 15;
      maskl[(kt * 64 + 8 * wid + (r >> 1)) * 2 + (r & 1)] = 0xffffffffu;
    }
  } else {
    bf16x8 iq[4];
    {
      int ql = 8 * wid + (l32 >> 2);
      if (ql > nq - 1) ql = nq - 1;
      const u16* p = (const u16*)(ws + R_QI) + (qrow0 + ql) * 256 + (l32 & 3) * 64 + g * 8;
      for (int ks = 0; ks < 4; ++ks) iq[ks] = ld16(p + ks * 16);
    }
    f32x4 wv[4];
    float scl[4];
    for (int i = 0; i < 4; ++i) {
      int ql = 8 * wid + g + 2 * i;
      if (ql > nq - 1) ql = nq - 1;
      wv[i] = *(const f32x4*)((const float*)(ws + R_WI) + (qrow0 + ql) * 4);
      const float s2 = 32.0f * (wv[i][0] * wv[i][0] + wv[i][1] * wv[i][1] + wv[i][2] * wv[i][2] + wv[i][3] * wv[i][3]);
      scl[i] = rsqrtf(s2 + 1e-30f);
    }
#define RELU_(x) __builtin_amdgcn_fmed3f((x), 0.f, 3.0e38f)
#define IDX_LOAD(kt, d0, d1)                                                                     \
  {                                                                                              \
    const u16* kp = KIb + (long)(kt)*4096 + lane * 8;                                            \
    for (int ks = 0; ks < 4; ++ks) { d0[ks] = ld16(kp + ks * 512); d1[ks] = ld16(kp + 2048 + ks * 512); } \
  }
#define IDX_COMPUTE(kf0, kf1, sc)                                                                \
  {                                                                                              \
    f32x16 a0 = {}, a1 = {};                                                                     \
    for (int ks = 0; ks < 4; ++ks) { a0 = MFMA32(iq[ks], kf0[ks], a0); a1 = MFMA32(iq[ks], kf1[ks], a1); } \
    for (int i = 0; i < 4; ++i) {                                                                \
      const f32x4 w4 = wv[i];                                                                    \
      float s0 = w4[0] * RELU_(a0[4 * i]);                                                  \
      s0 = fmaf(w4[1], RELU_(a0[4 * i + 1]), s0);                                           \
      s0 = fmaf(w4[2], RELU_(a0[4 * i + 2]), s0);                                           \
      s0 = fmaf(w4[3], RELU_(a0[4 * i + 3]), s0);                                           \
      float s1 = w4[0] * RELU_(a1[4 * i]);                                                  \
      s1 = fmaf(w4[1], RELU_(a1[4 * i + 1]), s1);                                           \
      s1 = fmaf(w4[2], RELU_(a1[4 * i + 2]), s1);                                           \
      s1 = fmaf(w4[3], RELU_(a1[4 * i + 3]), s1);                                           \
      sc[i][0] = s0; sc[i][1] = s1;                                                              \
    }                                                                                            \
  }
#define IDX_SCORES(kt, sc)                                                                       \
  {                                                                                              \
    bf16x8 kf0_[4], kf1_[4];                                                                     \
    IDX_LOAD(kt, kf0_, kf1_);                                                                    \
    IDX_COMPUTE(kf0_, kf1_, sc);                                                                 \
  }
#define IDX_PIPE_BEGIN() bf16x8 nk0[4], nk1[4]; IDX_LOAD(0, nk0, nk1);
#define IDX_PIPE_STEP(kt, sc)                                                                    \
  {                                                                                              \
    f32x16 a0 = {}, a1 = {};                                                                     \
    for (int ks = 0; ks < 4; ++ks) { a0 = MFMA32(iq[ks], nk0[ks], a0); a1 = MFMA32(iq[ks], nk1[ks], a1); } \
    if ((kt) + 1 < ntiles) IDX_LOAD((kt) + 1, nk0, nk1);     \
    for (int i = 0; i < 4; ++i) {                                                                \
      const f32x4 w4 = wv[i];                                                                    \
      float s0 = w4[0] * RELU_(a0[4 * i]);                                                  \
      s0 = fmaf(w4[1], RELU_(a0[4 * i + 1]), s0);                                           \
      s0 = fmaf(w4[2], RELU_(a0[4 * i + 2]), s0);                                           \
      s0 = fmaf(w4[3], RELU_(a0[4 * i + 3]), s0);                                           \
      float s1 = w4[0] * RELU_(a1[4 * i]);                                                  \
      s1 = fmaf(w4[1], RELU_(a1[4 * i + 1]), s1);                                           \
      s1 = fmaf(w4[2], RELU_(a1[4 * i + 2]), s1);                                           \
      s1 = fmaf(w4[3], RELU_(a1[4 * i + 3]), s1);                                           \
      sc[i][0] = s0; sc[i][1] = s1;                                                              \
    }                                                                                            \
  }
    for (int i = lane; i < 2048; i += 64) hist[i] = 0u;
    { IDX_PIPE_BEGIN();
#pragma unroll 1
    for (int kt = 0; kt < ntiles; ++kt) {
      float sc[4][2];
      IDX_PIPE_STEP(kt, sc);
      if (kt * 64 + 64 <= nkeys) {
        for (int hf = 0; hf < 2; ++hf)
          for (int i = 0; i < 4; ++i) {
            const int bn = score_bin(sc[i][hf], scl[i]);
            atomicAdd(&hist[(g + 2 * i) * 256 + (bn >> 1)], 1u << (16 * (bn & 1)));
          }
      } else {
        for (int hf = 0; hf < 2; ++hf) {
          const bool valid = (kt * 64 + hf * 32 + l32) < nkeys;
          for (int i = 0; i < 4; ++i)
            if (valid) {
              const int bn = score_bin(sc[i][hf], scl[i]);
              atomicAdd(&hist[(g + 2 * i) * 256 + (bn >> 1)], 1u << (16 * (bn & 1)));
            }
        }
      }
    }
    }
    for (int q = 0; q < 8; ++q) {
      const unsigned* hq = hist + q * 256 + lane * 4;
      unsigned cnt[8];
      for (int t = 0; t < 4; ++t) { const unsigned w = hq[t]; cnt[2 * t] = w & 0xffffu; cnt[2 * t + 1] = w >> 16; }
      unsigned tot = 0;
      for (int t = 0; t < 8; ++t) tot += cnt[t];
      unsigned suf = tot;
      for (int d = 1; d < 64; d <<= 1) {
        unsigned o = __shfl_down(suf, d);
        if (lane + d < 64) suf += o;
      }
      const unsigned above = suf - tot;
      if (above < 256u && suf >= 256u) {
        unsigned a = above;
        int bin = 0, nn = 0; unsigned cb = 0; bool found = false;
        for (int t = 7; t >= 0; --t) {
          if (!found && a + cnt[t] >= 256u) { bin = t; nn = 256 - (int)a; cb = cnt[t]; found = true; }
          if (!found) a += cnt[t];
        }
        resl[q * 4] = lane * 8 + bin;
        resl[q * 4 + 1] = nn;
        resl[q * 4 + 2] = (int)cb;
      }
    }
    int bst[4], nd[4];
    bool ovf = false;
    for (int i = 0; i < 4; ++i) {
      const int q = g + 2 * i;
      bst[i] = resl[q * 4];
      nd[i] = resl[q * 4 + 1];
      ovf = ovf || (bst[i] != 255 && resl[q * 4 + 2] > CAND_CAP);
    }
    const bool wave_ovf = __ballot(ovf) != 0ull;
    unsigned klo[4], khi[4];
    {
      unsigned* thrL = (unsigned*)(smem + L_CL) + wid * 32;
      float* sclL = (float*)(thrL + 16);
      if (l32 == 0) for (int i = 0; i < 4; ++i) sclL[g + 2 * i] = scl[i];
      if (lane < 16) {
        const int q = lane >> 1, b = resl[q * 4] + (lane & 1);
        const float isg = sclL[q];
        unsigned lo = 0x007FFFFFu, hi = 0xFF800000u;
        unsigned K = 0xFFFFFFFFu;
        if (b <= 511) {
          for (int it = 0; it < 32; ++it) {
            if (lo >= hi) break;
            const unsigned mid = lo + ((hi - lo) >> 1);
            const unsigned u = (mid & 0x80000000u) ? (mid & 0x7FFFFFFFu) : ~mid;
            const int bn = score_bin(__uint_as_float(u), isg);
            if (bn >= b) hi = mid; else lo = mid + 1u;
          }
          K = hi;
        }
        thrL[lane] = K;
      }
      for (int i = 0; i < 4; ++i) { klo[i] = thrL[(g + 2 * i) * 2]; khi[i] = thrL[(g + 2 * i) * 2 + 1]; }
    }
    __syncthreads();
    if (!wave_ovf) {
      int seen[4] = {0, 0, 0, 0};
      int cbase[4] = {0, 0, 0, 0};
      const unsigned ltmask = (1u << l32) - 1u;
      const bool anyzb = __ballot(bst[0] == 255 || bst[1] == 255 || bst[2] == 255 || bst[3] == 255) != 0ull;
      IDX_PIPE_BEGIN();
#pragma unroll 1
      for (int kt = 0; kt < ntiles; ++kt) {
        float sc[4][2];
        IDX_PIPE_STEP(kt, sc);
        const bool tail = (kt * 64 + 64 > nkeys);
        unsigned mv = 0u;
        for (int hf = 0; hf < 2; ++hf) {
          const bool valid = !tail || ((kt * 64 + hf * 32 + l32) < nkeys);
          for (int i = 0; i < 4; ++i) {
            const unsigned key = mono_key(sc[i][hf]);
            bool sel = valid && (key >= khi[i]);
            const bool inb = valid && (key >= klo[i]) && (key < khi[i]);
            const bool zb = (bst[i] == 255);
            if (anyzb) {
              const unsigned long long bal = __ballot(inb && zb);
              const unsigned mym = g ? (unsigned)(bal >> 32) : (unsigned)bal;
              const int rank = __popc(mym & ltmask);
              sel = sel || (inb && zb && (seen[i] + rank < nd[i]));
              seen[i] += __popc(mym);
            }
            const bool cand = inb && !zb;
            const unsigned long long cb = __ballot(cand);
            if (cb != 0ull) {
              const unsigned mym = g ? (unsigned)(cb >> 32) : (unsigned)cb;
              const int slot = cbase[i] + __popc(mym & ltmask);
              if (cand && slot < CAND_CAP)
                lst[(g + 2 * i) * CAND_CAP + slot] = make_uint2(key, (unsigned)(kt * 64 + hf * 32 + l32));
              cbase[i] += __popc(mym);
            }
            const unsigned long long sb = __ballot(sel);
            mv = (lane == (2 * i) * 2 + hf) ? (unsigned)sb : mv;
            mv = (lane == (2 * i + 1) * 2 + hf) ? (unsigned)(sb >> 32) : mv;
          }
        }
        if (lane < 16) maskl[(kt * 64 + 8 * wid) * 2 + lane] = mv;
      }
      if (l32 == 0) for (int i = 0; i < 4; ++i) ccnt[g + 2 * i] = (unsigned)cbase[i];
      for (int q = 0; q < 8; ++q) {
        const int qb = resl[q * 4], qn = resl[q * 4 + 1];
        int n = (int)ccnt[q];
        if (n > CAND_CAP) n = CAND_CAP;
        if (qb == 255) n = 0;
        const uint2* lq = lst + q * CAND_CAP;
        const uint2 m0 = (lane < n) ? lq[lane] : make_uint2(0u, 0u);
        const uint2 m1 = (lane + 64 < n) ? lq[lane + 64] : make_uint2(0u, 0u);
        int gt0 = 0, gt1 = 0;
        for (int t = 0; t < n; ++t) {
          const uint2 o = lq[t];
          gt0 += (o.x > m0.x || (o.x == m0.x && o.y < m0.y)) ? 1 : 0;
          gt1 += (o.x > m1.x || (o.x == m1.x && o.y < m1.y)) ? 1 : 0;
        }
        if (lane < n && gt0 < qn)
          atomicOr(&maskl[((m0.y >> 6) * 64 + 8 * wid + q) * 2 + ((m0.y >> 5) & 1)], 1u << (m0.y & 31));
        if (lane + 64 < n && gt1 < qn)
          atomicOr(&maskl[((m1.y >> 6) * 64 + 8 * wid + q) * 2 + ((m1.y >> 5) & 1)], 1u << (m1.y & 31));
      }
    } else {
      unsigned tau[4] = {0u, 0u, 0u, 0u};
      int need[4] = {256, 256, 256, 256};
      for (int pass = 0; pass < 4; ++pass) {
        const int shift = 24 - 8 * pass;
        for (int i = lane; i < 1024; i += 64) cl[i] = 0u;
#pragma unroll 1
        for (int kt = 0; kt < ntiles; ++kt) {
          float sc[4][2];
          IDX_SCORES(kt, sc);
          for (int hf = 0; hf < 2; ++hf) {
            const bool valid = (kt * 64 + hf * 32 + l32) < nkeys;
            for (int i = 0; i < 4; ++i) {
              const unsigned key = mono_key(sc[i][hf]);
              const bool inb = valid && (pass == 0 || ((key >> (shift + 8)) == tau[i]));
              const unsigned dg = (key >> shift) & 255u;
              if (inb) atomicAdd(&cl[(g + 2 * i) * 128 + (dg >> 1)], 1u << (16 * (dg & 1)));
            }
          }
        }
        for (int q = 0; q < 8; ++q) {
          const int ndq = __shfl(need[q >> 1], (q & 1) * 32);
          const unsigned* hq = cl + q * 128 + lane * 2;
          const unsigned w0 = hq[0], w1 = hq[1];
          unsigned c0 = w0 & 0xffffu, c1 = w0 >> 16, c2 = w1 & 0xffffu, c3 = w1 >> 16;
          unsigned tot = c0 + c1 + c2 + c3;
          unsigned suf = tot;
          for (int d = 1; d < 64; d <<= 1) {
            unsigned o = __shfl_down(suf, d);
            if (lane + d < 64) suf += o;
          }
          const unsigned above = suf - tot;
          if (above < (unsigned)ndq && suf >= (unsigned)ndq) {
            unsigned a = above;
            int bin, nn;
            if (a + c3 >= (unsigned)ndq) { bin = 3; nn = ndq - a; }
            else { a += c3; if (a + c2 >= (unsigned)ndq) { bin = 2; nn = ndq - a; }
            else { a += c2; if (a + c1 >= (unsigned)ndq) { bin = 1; nn = ndq - a; }
            else { a += c1; bin = 0; nn = ndq - a; } } }
            resl[q * 4] = lane * 4 + bin;
            resl[q * 4 + 1] = nn;
          }
        }
        for (int i = 0; i < 4; ++i) {
          const int q = g + 2 * i;
          tau[i] = (tau[i] << 8) | (unsigned)resl[q * 4];
          need[i] = resl[q * 4 + 1];
        }
      }
      int seen[4] = {0, 0, 0, 0};
#pragma unroll 1
      for (int kt = 0; kt < ntiles; ++kt) {
        float sc[4][2];
        IDX_SCORES(kt, sc);
        for (int hf = 0; hf < 2; ++hf) {
          const bool valid = (kt * 64 + hf * 32 + l32) < nkeys;
          for (int i = 0; i < 4; ++i) {
            const unsigned key = mono_key(sc[i][hf]);
            const bool eq = valid && (key == tau[i]);
            const unsigned long long bal = __ballot(eq);
            const unsigned mym = g ? (unsigned)(bal >> 32) : (unsigned)bal;
            const int rank = __popc(mym & ((1u << l32) - 1u));
            const bool tsel = eq && (seen[i] + rank < need[i]);
            seen[i] += __popc(mym);
            const bool sel = (valid && key > tau[i]) || tsel;
            const unsigned long long sb = __ballot(sel);
            if (lane == 0) {
              maskl[(kt * 64 + 8 * wid + 2 * i) * 2 + hf] = (unsigned)sb;
              maskl[(kt * 64 + 8 * wid + 2 * i + 1) * 2 + hf] = (unsigned)(sb >> 32);
            }
          }
        }
      }
    }
#undef IDX_SCORES
#undef IDX_LOAD
#undef IDX_COMPUTE
#undef IDX_PIPE_BEGIN
#undef IDX_PIPE_STEP
  }
  __syncthreads();
  {
    const float* t5g = (const float*)(ws + W_T5);
    float* t5w = (float*)(smem + L_T5);
    for (int i = tid_; i < 8 * T5N; i += 512) t5w[i] = t5g[i] - t5g[(i / T5N) * T5N];
  }
  __syncthreads();

  const int h = wid;
  bf16x8 qf[2][4];
  for (int qh = 0; qh < 2; ++qh) {
    int ql = qh * 32 + l32;
    if (ql > nq - 1) ql = nq - 1;
    const u16* p = (const u16*)(ws + R_QA) + (qrow0 + ql) * 512 + h * 64 + g * 8;
    for (int ks = 0; ks < 4; ++ks) qf[qh][ks] = ld16(p + ks * 16);
  }
  f32x16 oacc[2][2];
  for (int a = 0; a < 2; ++a) for (int q = 0; q < 2; ++q) for (int r = 0; r < 16; ++r) oacc[a][q][r] = 0.f;
  float mrun[2] = {-1e30f, -1e30f}, lrun[2] = {0.f, 0.f};
  const u16* kbase = Kb + (long)h * 2048 + lane * 8;
  const u16* vbase = VTb + (long)h * 2048 + lane * 8;
  bf16x8 kfN[4], vfN[2][2];
  for (int ks = 0; ks < 4; ++ks) kfN[ks] = ld16(kbase + ks * 512);
  for (int dh = 0; dh < 2; ++dh)
    for (int s = 0; s < 2; ++s) vfN[dh][s] = ld16(vbase + (s * 2 + dh) * 512);
  const int nhalf = ntiles * 2;
#pragma unroll 1
  for (int hh = 0; hh < nhalf; ++hh) {
    const int kt = hh >> 1, kh = hh & 1;
    const long key0 = (long)hh * 32;
    const bool farT = (qpos0 - kt * 64) >= 1214;
    f32x16 sacc[2];
    for (int qh = 0; qh < 2; ++qh) {
      f32x16 a = {};
      for (int ks = 0; ks < 4; ++ks) a = MFMA32(kfN[ks], qf[qh][ks], a);
      sacc[qh] = a;
    }
    if (hh + 1 < nhalf) {
      const u16* kp = kbase + (long)(hh + 1) * 16384;
      for (int ks = 0; ks < 4; ++ks) kfN[ks] = ld16(kp + ks * 512);
    }
    for (int qh = 0; qh < 2; ++qh) {
      const int mw = (int)(maskl[(kt * 64 + qh * 32 + l32) * 2 + kh] >> (4 * g));
      const int relb = (int)key0 + 4 * g - (qpos0 + qh * 32 + l32) + T5OFF;
      float mx = -1e30f;
      if (!farT) {
        for (int r = 0; r < 16; ++r) sacc[qh][r] += t5l[relb + (r & 3) + 8 * (r >> 2)];
      }
      for (int r = 0; r < 16; ++r) {
        float l = sacc[qh][r];
        const unsigned keep = (unsigned)__builtin_amdgcn_sbfe(mw, (r & 3) + 8 * (r >> 2), 1);
        l = __uint_as_float((__float_as_uint(l) & keep) | (0xFF800000u & ~keep));
        sacc[qh][r] = l;
        mx = fmaxf(mx, l);
      }
      mx = fmaxf(mx, __shfl_xor(mx, 32));
      if (__ballot(mx > mrun[qh]) != 0ull) {
        const float mnew = fmaxf(mrun[qh], mx);
        const float alpha = __builtin_amdgcn_exp2f(mrun[qh] - mnew);
        mrun[qh] = mnew;
        lrun[qh] *= alpha;
        for (int dh = 0; dh < 2; ++dh)
          for (int r = 0; r < 16; ++r) oacc[dh][qh][r] *= alpha;
      }
      const float mcur = mrun[qh];
      float ps = 0.f;
      for (int r = 0; r < 16; ++r) {
        const float p = __builtin_amdgcn_exp2f(sacc[qh][r] - mcur);
        sacc[qh][r] = p;
        ps += p;
      }
      lrun[qh] += ps;
    }
    for (int qh = 0; qh < 2; ++qh)
      for (int s = 0; s < 2; ++s) {
        bf16x8 pf = packacc8(sacc[qh], s);
        for (int dh = 0; dh < 2; ++dh) oacc[dh][qh] = MFMA32(vfN[dh][s], pf, oacc[dh][qh]);
      }
    if (hh + 1 < nhalf) {
      const u16* vp = vbase + (long)(hh + 1) * 16384;
      for (int dh = 0; dh < 2; ++dh)
        for (int s = 0; s < 2; ++s) vfN[dh][s] = ld16(vp + (s * 2 + dh) * 512);
    }
  }
  for (int qh = 0; qh < 2; ++qh) {
    float lt = lrun[qh] + __shfl_xor(lrun[qh], 32);
    const float inv = 1.0f / lt;
    const int ql = qh * 32 + l32;
    if (ql < nq) {
      u16* ap = (u16*)(ws + R_QA) + (qrow0 + ql) * 512 + h * 64;
      for (int dh = 0; dh < 2; ++dh)
        for (int i = 0; i < 4; ++i) {
          const int d = dh * 32 + 4 * g + 8 * i;
          *(uint2*)(ap + d) = pack4(oacc[dh][qh][4 * i] * inv, oacc[dh][qh][4 * i + 1] * inv, oacc[dh][qh][4 * i + 2] * inv,
                                    oacc[dh][qh][4 * i + 3] * inv);
        }
    }
  }
}

DI void ret_item(const Params& P, unsigned char* smem, bool samp, int b, int h) {
  const int tid_ = launder_tid();
  const int wid = __builtin_amdgcn_readfirstlane(tid_ >> 6), lane = tid_ & 63, l32 = lane & 31, g = lane >> 5;
  unsigned char* ws = P.ws;
  asm volatile("" : "+s"(ws));
  const int C = samp ? 32 : 64, nchunks = samp ? 1 : 128;
  const long row0 = samp ? (NTP + b * 32) : (long)b * 8192;
  const u16* qb = (const u16*)(ws + R_QR) + row0 * 512 + h * 64;
  const u16* kb = (const u16*)(ws + R_KR) + row0 * 512 + h * 64;
  const long ldt = samp ? 32 : 8192;
  const u16* krt = samp ? ((const u16*)(ws + R_SKRT) + (long)(b * 8 + h) * 64 * 32) : ((const u16*)(ws + R_KRT) + (long)(b * 8 + h) * 64 * 8192);
  const u16* vrt = samp ? ((const u16*)(ws + R_SVRT) + (long)(b * 8 + h) * 128 * 32) : ((const u16*)(ws + R_VRT) + (long)(b * 8 + h) * 128 * 8192);
  u16* grp = (u16*)(ws + R_GR) + row0 * 1024 + h * 128;
  u16* sbuf = (u16*)(smem + L_SBUF);
  float2* stat = (float2*)(smem + L_STAT);
  const int nh = wid >> 2, eb = wid & 3;
  const int dh = nh;
  const float lg = log_gamma_h(h);
  const float gC = expf(lg * (float)C), ginvC = expf(-lg * (float)C);
  f32x16 S;
  for (int r = 0; r < 16; ++r)
    S[r] = samp ? P.state[((long)(b * 8 + h) * 64 + dh * 32 + crow(r, g)) * 128 + eb * 32 + l32] : 0.f;
  int cur = 0;
  __syncthreads();
  for (int i = 0; i < 4; ++i) {
    const int d0 = dh * 32 + 4 * g + 8 * i;
    *(uint2*)(sbuf + (eb * 32 + l32) * SLD + d0) = pack4(S[4 * i], S[4 * i + 1], S[4 * i + 2], S[4 * i + 3]);
  }
  __syncthreads();
  const bool act = !(samp && nh == 1);
#pragma unroll 1
  for (int c = 0; c < nchunks; ++c) {
    const long t0 = (long)c * 64;
    f32x16 oT = {};
    bf16x8 uaf[4], ubf[4];
    for (int ks = 0; ks < 4; ++ks)
      if (ks < C / 16) {
        uaf[ks] = ld16(krt + (long)(dh * 32 + l32) * ldt + t0 + ks * 16 + g * 8);
        ubf[ks] = ld16(vrt + (long)(eb * 32 + l32) * ldt + t0 + ks * 16 + g * 8);
      }
    uint2 sgv[4];
    if (act) {
      const u16* rp0 = grp + (t0 + nh * 32 + l32) * 1024 + eb * 32;
      for (int i = 0; i < 4; ++i) sgv[i] = *(const uint2*)(rp0 + 4 * g + 8 * i);
    }
    if (act) {
      bf16x8 qf[4];
      {
        const u16* p = qb + (t0 + nh * 32 + l32) * 512 + g * 8;
        for (int ks = 0; ks < 4; ++ks) qf[ks] = ld16(p + ks * 16);
      }
      for (int mh = 0; mh <= nh; ++mh) {
        bf16x8 kf[4];
        const u16* p = kb + (t0 + mh * 32 + l32) * 512 + g * 8;
        for (int ks = 0; ks < 4; ++ks) kf[ks] = ld16(p + ks * 16);
        f32x16 inn = {};
        for (int ks = 0; ks < 4; ++ks) inn = MFMA32(kf[ks], qf[ks], inn);
        const int ncol = nh * 32 + l32;
        for (int r = 0; r < 16; ++r) {
          const int m = mh * 32 + crow(r, g);
          inn[r] = (ncol >= m) ? inn[r] * ginvC : 0.f;
        }
        for (int s = 0; s < 2; ++s) {
          const u16* vp = vrt + (long)(eb * 32 + l32) * ldt + t0 + mh * 32 + 16 * s + 4 * g;
          bf16x8 vf = ld8x2(vp, vp + 8);
          oT = MFMA32(vf, packacc8(inn, s), oT);
        }
      }
      const u16* sp = sbuf + cur * (128 * SLD) + (eb * 32 + l32) * SLD + g * 8;
      for (int ks = 0; ks < 4; ++ks) {
        bf16x8 sf = *reinterpret_cast<const bf16x8*>(sp + ks * 16);
        oT = MFMA32(sf, qf[ks], oT);
      }
      float s1 = 0.f, s2 = 0.f;
      for (int r = 0; r < 16; ++r) { s1 += oT[r]; s2 += oT[r] * oT[r]; }
      s1 += __shfl_xor(s1, 32);
      s2 += __shfl_xor(s2, 32);
      if (g == 0) stat[(nh * 4 + eb) * 32 + l32] = make_float2(s1, s2);
    }
    __syncthreads();
    if (act) {
      float s1 = 0.f, s2 = 0.f;
      for (int e = 0; e < 4; ++e) { float2 v = stat[(nh * 4 + e) * 32 + l32]; s1 += v.x; s2 += v.y; }
      const float mean = s1 * (1.0f / 128.0f);
      const float var = fmaxf(s2 * (1.0f / 128.0f) - mean * mean, 0.f);
      const float rstd = rsqrtf(var + 1e-6f);
      u16* rp = grp + (t0 + nh * 32 + l32) * 1024 + eb * 32;
      const float* gg = P.gng + h * 128 + eb * 32;
      for (int i = 0; i < 4; ++i) {
        const int e = 4 * g + 8 * i;
        const uint2 sg = sgv[i];
        f32x4 gv = *(const f32x4*)(gg + e);
        float r0 = (oT[4 * i] - mean) * rstd * gv[0], r1 = (oT[4 * i + 1] - mean) * rstd * gv[1];
        float r2 = (oT[4 * i + 2] - mean) * rstd * gv[2], r3 = (oT[4 * i + 3] - mean) * rstd * gv[3];
        *(uint2*)(rp + e) = pack4(r0 * bflo(sg.x), r1 * bfhi(sg.x), r2 * bflo(sg.y), r3 * bfhi(sg.y));
      }
    }
    for (int r = 0; r < 16; ++r) S[r] *= gC;
    for (int ks = 0; ks < 4; ++ks)
      if (ks < C / 16) S = MFMA32(uaf[ks], ubf[ks], S);
    {
      u16* sn = sbuf + (cur ^ 1) * (128 * SLD);
      for (int i = 0; i < 4; ++i) {
        const int d0 = dh * 32 + 4 * g + 8 * i;
        *(uint2*)(sn + (eb * 32 + l32) * SLD + d0) = pack4(S[4 * i], S[4 * i + 1], S[4 * i + 2], S[4 * i + 3]);
      }
    }
    __syncthreads();
    cur ^= 1;
  }
  float* so = P.out + (samp ? O_SS : O_SP) + (long)(b * 8 + h) * 64 * 128;
  for (int r = 0; r < 16; ++r) so[(long)(dh * 32 + crow(r, g)) * 128 + eb * 32 + l32] = S[r];
}

constexpr int ITEMS_PER_Q = 8 + 1 + 128 + 8;
DI void phase_mixers(const Params& P, unsigned char* smem) {
  unsigned* ctr = (unsigned*)(P.ws + W_CTR);
  int* itl = (int*)(smem + L_ITEM);
  for (int qq = 0; qq < 8; ++qq) {
    const int b = (blockIdx.x + qq) & 7;
    for (;;) {
      __syncthreads();
      if (threadIdx.x == 0) itl[0] = (int)atomicAdd(ctr + b, 1u);
      __syncthreads();
      const int it = itl[0];
      if (it >= ITEMS_PER_Q) break;
      if (it < 8) ret_item(P, smem, false, b, it);
      else if (it >= 137) ret_item(P, smem, true, b, it - 137);
      else attn_item(P, smem, it == 8, b, it == 8 ? 0 : 127 - (it - 9));
    }
  }
}

DI void phase_merge(const Params& P, unsigned char* smem) {
  const u16* WPA = (const u16*)(P.ws + W_WPA);
  const u16* WPR = (const u16*)(P.ws + W_WPR);
  const u16* Aa = (const u16*)(P.ws + R_QA);
  const u16* Rr = (const u16*)(P.ws + R_GR);
  const u16* GA = (const u16*)(P.ws + R_GA);
  const u16* GRR = (const u16*)(P.ws + R_GRR);
  u16* MG = (u16*)(P.ws + R_MERGED);
  const int nft = 4, total = 257 * nft;
  for (int u = blockIdx.x; u < total; u += gridDim.x) {
    int tt, ft;
    unit_map(u, nft, 4, tt, ft);
    {
      acc_t acc;
      acc_zero(acc);
      __syncthreads();
      gemm_core(acc, WPA, 512, Aa, 512, 512, ft * 256, tt * 256, (u16*)smem);
      const int tid_ = launder_tid(); const int wid = tid_ >> 6, lane = tid_ & 63, wr = wid >> 2, wc = wid & 3, fr = lane & 15, fq = lane >> 4;
#pragma unroll
      for (int ai = 0; ai < 2; ++ai)
#pragma unroll
      for (int bj = 0; bj < 2; ++bj)
#pragma unroll
      for (int m = 0; m < 4; ++m)
#pragma unroll
      for (int n = 0; n < 2; ++n) {
        asm volatile("" ::: "memory");
        const long token = tt * 256 + bj * 128 + wc * 32 + n * 16 + fr;
        const int f = ft * 256 + ai * 128 + wr * 64 + m * 16 + fq * 4;
        uint2 a = *(const uint2*)(GA + token * 1024 + f);
        f32x4 v = acc[ai][bj][m][n];
        *(uint2*)(MG + token * 1024 + f) = pack4(v[0] * bflo(a.x), v[1] * bfhi(a.x), v[2] * bflo(a.y), v[3] * bfhi(a.y));
      }
    }
    {
      acc_t acc;
      acc_zero(acc);
      __syncthreads();
      gemm_core(acc, WPR, 1024, Rr, 1024, 1024, ft * 256, tt * 256, (u16*)smem);
      const int tid_ = launder_tid(); const int wid = tid_ >> 6, lane = tid_ & 63, wr = wid >> 2, wc = wid & 3, fr = lane & 15, fq = lane >> 4;
#pragma unroll
      for (int ai = 0; ai < 2; ++ai)
#pragma unroll
      for (int bj = 0; bj < 2; ++bj)
#pragma unroll
      for (int m = 0; m < 4; ++m)
#pragma unroll
      for (int n = 0; n < 2; ++n) {
        asm volatile("" ::: "memory");
        const long token = tt * 256 + bj * 128 + wc * 32 + n * 16 + fr;
        const int f = ft * 256 + ai * 128 + wr * 64 + m * 16 + fq * 4;
        uint2 r = *(const uint2*)(GRR + token * 1024 + f);
        uint2 p = *(const uint2*)(MG + token * 1024 + f);
        f32x4 v = acc[ai][bj][m][n];
        *(uint2*)(MG + token * 1024 + f) = pack4(bflo(p.x) + v[0] * bflo(r.x), bfhi(p.x) + v[1] * bfhi(r.x),
                                                 bflo(p.y) + v[2] * bflo(r.y), bfhi(p.y) + v[3] * bfhi(r.y));
      }
    }
  }
}

DI void phase_oproj(const Params& P, unsigned char* smem) {
  const u16* WO = (const u16*)(P.ws + W_WO);
  const u16* MG = (const u16*)(P.ws + R_MERGED);
  u16* TB = (u16*)(P.ws + R_TB);
  const u16* XBr = (const u16*)((unsigned char*)P.out + OB_XB);
  const int nft = 4, total = 257 * nft;
  for (int u = blockIdx.x; u < total; u += gridDim.x) {
    int tt, ft;
    unit_map(u, nft, 4, tt, ft);
    acc_t acc;
    acc_zero(acc);
    __syncthreads();
    gemm_core(acc, WO, 1024, MG, 1024, 1024, ft * 256, tt * 256, (u16*)smem);
    { const int tid_ = launder_tid(); const int wid = tid_ >> 6, lane = tid_ & 63, wr = wid >> 2, wc = wid & 3, fr = lane & 15, fq = lane >> 4;
#pragma unroll
    for (int ai = 0; ai < 2; ++ai)
#pragma unroll
    for (int bj = 0; bj < 2; ++bj)
#pragma unroll
    for (int m = 0; m < 4; ++m)
#pragma unroll
    for (int n = 0; n < 2; ++n) {
      asm volatile("" ::: "memory");
      const long token = tt * 256 + bj * 128 + wc * 32 + n * 16 + fr;
      const int f = ft * 256 + ai * 128 + wr * 64 + m * 16 + fq * 4;
      const uint2 xb2 = *(const uint2*)(XBr + token * 1024 + f);
      const f32x4 x = {bflo(xb2.x), bfhi(xb2.x), bflo(xb2.y), bfhi(xb2.y)};
      const f32x4 tv = acc[ai][bj][m][n] + x * ALPHA;
      *(uint2*)(TB + token * 1024 + f) = pack4(tv[0], tv[1], tv[2], tv[3]);
    }
    }
  }
}

template <bool TO_BF16>
DI void phase_ln(const Params& P, const float* gam, const float* bet) {
  const int wid = threadIdx.x >> 6, lane = threadIdx.x & 63;
  float* Y = P.out + O_Y;
  u16* X1 = (u16*)(P.ws + R_X1);
  const u16* SRC = (const u16*)(P.ws + (TO_BF16 ? R_TB : R_T2B));
  for (long row = (long)blockIdx.x * 8 + wid; row < MTOK; row += (long)gridDim.x * 8) {
    const u16* src = SRC + row * 1024;
    float v[16];
    float s = 0.f;
    for (int k = 0; k < 2; ++k) {
      const uint4 u = *(const uint4*)(src + k * 512 + lane * 8);
      v[8 * k + 0] = bflo(u.x); v[8 * k + 1] = bfhi(u.x); v[8 * k + 2] = bflo(u.y); v[8 * k + 3] = bfhi(u.y);
      v[8 * k + 4] = bflo(u.z); v[8 * k + 5] = bfhi(u.z); v[8 * k + 6] = bflo(u.w); v[8 * k + 7] = bfhi(u.w);
    }
    for (int e = 0; e < 16; ++e) s += v[e];
    for (int d = 1; d < 64; d <<= 1) s += __shfl_xor(s, d);
    const float mean = s * (1.0f / 1024.0f);
    float s2 = 0.f;
    for (int e = 0; e < 16; ++e) { const float d = v[e] - mean; s2 += d * d; }
    for (int d = 1; d < 64; d <<= 1) s2 += __shfl_xor(s2, d);
    const float rstd = rsqrtf(s2 * (1.0f / 1024.0f) + 1e-5f);
    for (int k = 0; k < 2; ++k) {
      const int c = k * 512 + lane * 8;
      f32x4 g0 = *(const f32x4*)(gam + c), g1 = *(const f32x4*)(gam + c + 4), b0 = *(const f32x4*)(bet + c), b1 = *(const f32x4*)(bet + c + 4), r0, r1;
      for (int j = 0; j < 4; ++j) { r0[j] = (v[8 * k + j] - mean) * rstd * g0[j] + b0[j]; r1[j] = (v[8 * k + 4 + j] - mean) * rstd * g1[j] + b1[j]; }
      if (TO_BF16) *(uint4*)(X1 + row * 1024 + c) = pk8(r0, r1);
      else { __builtin_nontemporal_store(r0, (f32x4*)(Y + row * 1024 + c)); __builtin_nontemporal_store(r1, (f32x4*)(Y + row * 1024 + c + 4)); }
    }
  }
}

DI void phase_ffn_up(const Params& P, unsigned char* smem) {
  const u16* WGU = (const u16*)(P.ws + W_WGU);
  const u16* X1 = (const u16*)(P.ws + R_X1);
  u16* HM = (u16*)(P.ws + R_HMID);
  const int nft = 22, total = 257 * nft;
  for (int u = blockIdx.x; u < total; u += gridDim.x) {
    int tt, ft;
    unit_map(u, nft, 2, tt, ft);
    acc_t acc;
    acc_zero(acc);
    __syncthreads();
    gemm_core(acc, WGU, 1024, X1, 1024, 1024, ft * 256, tt * 256, (u16*)smem);
    { const int tid_ = launder_tid(); const int wid = tid_ >> 6, lane = tid_ & 63, wr = wid >> 2, wc = wid & 3, fr = lane & 15, fq = lane >> 4;
#pragma unroll
    for (int ai = 0; ai < 2; ++ai)
#pragma unroll
    for (int bj = 0; bj < 2; ++bj)
#pragma unroll
    for (int n = 0; n < 2; ++n)
#pragma unroll
    for (int m = 0; m < 2; ++m) {
      asm volatile("" ::: "memory");
      const long token = tt * 256 + bj * 128 + wc * 32 + n * 16 + fr;
      const int jj = (ft * 4 + ai * 2 + wr) * 32 + m * 16 + fq * 4;
      f32x4 gt = acc[ai][bj][m][n], up = acc[ai][bj][m + 2][n];
      *(uint2*)(HM + token * DFF + jj) = pack4(siluf_(gt[0]) * up[0], siluf_(gt[1]) * up[1], siluf_(gt[2]) * up[2], siluf_(gt[3]) * up[3]);
    }
    }
  }
}

DI void phase_ffn_down(const Params& P, unsigned char* smem) {
  const u16* WDN = (const u16*)(P.ws + W_WDN);
  const u16* HM = (const u16*)(P.ws + R_HMID);
  const u16* X1 = (const u16*)(P.ws + R_X1);
  u16* T2B = (u16*)(P.ws + R_T2B);
  const int nft = 4, total = 257 * nft;
  for (int u = blockIdx.x; u < total; u += gridDim.x) {
    int tt, ft;
    unit_map(u, nft, 4, tt, ft);
    acc_t acc;
    acc_zero(acc);
    __syncthreads();
    gemm_core(acc, WDN, DFF, HM, DFF, DFF, ft * 256, tt * 256, (u16*)smem);
    { const int tid_ = launder_tid(); const int wid = tid_ >> 6, lane = tid_ & 63, wr = wid >> 2, wc = wid & 3, fr = lane & 15, fq = lane >> 4;
#pragma unroll
    for (int ai = 0; ai < 2; ++ai)
#pragma unroll
    for (int bj = 0; bj < 2; ++bj)
#pragma unroll
    for (int m = 0; m < 4; ++m)
#pragma unroll
    for (int n = 0; n < 2; ++n) {
      asm volatile("" ::: "memory");
      const long token = tt * 256 + bj * 128 + wc * 32 + n * 16 + fr;
      const int f = ft * 256 + ai * 128 + wr * 64 + m * 16 + fq * 4;
      uint2 x = *(const uint2*)(X1 + token * 1024 + f);
      f32x4 v = acc[ai][bj][m][n];
      v[0] += ALPHA * bflo(x.x); v[1] += ALPHA * bfhi(x.x); v[2] += ALPHA * bflo(x.y); v[3] += ALPHA * bfhi(x.y);
      *(uint2*)(T2B + token * 1024 + f) = pack4(v[0], v[1], v[2], v[3]);
    }
    }
  }
}


DI void phase_dbg(const Params& P, unsigned char* smem, long off, long rows, int cols, long ld, int slot) {
  const u16* X = (const u16*)(P.ws + off);
  unsigned long long cs = 0; unsigned nf = 0;
  for (long i = (long)blockIdx.x * 512 + threadIdx.x; i < rows * cols; i += (long)gridDim.x * 512) {
    long r = i / cols; int c = (int)(i % cols);
    u16 v = X[r * ld + c];
    cs += (unsigned long long)v * (unsigned long long)((i % 1000003) + 1);
    if ((v & 0x7f80) == 0x7f80) nf++;
  }
  unsigned long long* acc = (unsigned long long*)(P.ws + W_CTR + 64) + slot * 2;
  atomicAdd(acc, cs);
  atomicAdd(acc + 1, (unsigned long long)nf);
}

constexpr int N_PHASES = 9;
#ifndef REP_MASK
#define REP_MASK 0x0
#endif

__global__ void __launch_bounds__(512) mega(Params P) {
  extern __shared__ __attribute__((aligned(16))) unsigned char smem[];
  cg::grid_group grid = cg::this_grid();
#define RUN_PHASE(k, CALL)                                         \
  if (P.ph_lo <= (k) && (k) < P.ph_hi) {                            \
    Params Q = P;                                                   \
    asm volatile("" : "+s"(Q.ws), "+s"(Q.out));                     \
    CALL;                                                           \
    if ((REP_MASK >> (k)) & 1) { grid.sync(); CALL; }               \
    if ((k) + 1 < P.ph_hi) grid.sync();                             \
  }
  RUN_PHASE(0, phase_prep(Q, smem))
  RUN_PHASE(1, phase_inproj(Q, smem))
  RUN_PHASE(2, phase_mixers(Q, smem))
  RUN_PHASE(3, phase_merge(Q, smem))
  RUN_PHASE(4, phase_oproj(Q, smem))
  RUN_PHASE(5, phase_ln<true>(Q, Q.ln1g, Q.ln1b))
  RUN_PHASE(6, phase_ffn_up(Q, smem))
  RUN_PHASE(7, phase_ffn_down(Q, smem))
  RUN_PHASE(8, phase_ln<false>(Q, Q.ln2g, Q.ln2b))
#undef RUN_PHASE
}

#ifndef N_LAUNCH_MODE
#define N_LAUNCH_MODE 1
#endif

extern "C" void kernel_launch(void* const* d_in, const int* in_sizes, int n_in, void* d_out, int out_size, void* d_ws,
                              size_t ws_size, hipStream_t stream) {
  static int grid = 0;
  if (grid == 0) {
    int dev = 0, cus = 0, per_cu = 0;
    hipGetDevice(&dev);
    hipDeviceGetAttribute(&cus, hipDeviceAttributeMultiprocessorCount, dev);
    if (hipFuncSetAttribute((const void*)mega, hipFuncAttributeMaxDynamicSharedMemorySize, LDS_BYTES) != hipSuccess) {
      fprintf(stderr, "hipFuncSetAttribute failed\n");
    }
    hipOccupancyMaxActiveBlocksPerMultiprocessor(&per_cu, (const void*)mega, 512, LDS_BYTES);
    if (per_cu < 1) per_cu = 1;
    grid = cus * 1;
    if ((size_t)R_END > ws_size) fprintf(stderr, "workspace too small: need %ld have %zu\n", (long)R_END, ws_size);
    (void)hipGetLastError();
  }
  Params p{};
  const float** pp = (const float**)&p;
  for (int i = 0; i < 21; ++i) pp[i] = (const float*)d_in[i];
  p.out = (float*)d_out;
  p.ws = (unsigned char*)d_ws;
#if N_LAUNCH_MODE == 1
  p.ph_lo = 0; p.ph_hi = N_PHASES;
  void* args[] = {&p};
  hipError_t e = hipLaunchCooperativeKernel((const void*)mega, dim3(grid), dim3(512), args, LDS_BYTES, stream);
  if (e != hipSuccess) fprintf(stderr, "cooperative launch failed: %s (grid %d)\n", hipGetErrorString(e), grid);
#else
  for (int ph = 0; ph < N_PHASES; ++ph) {
    p.ph_lo = ph; p.ph_hi = ph + 1;
    hipLaunchKernelGGL(mega, dim3(grid), dim3(512), LDS_BYTES, stream, p);
  }
#endif
}
```

```cpp
#include <hip/hip_runtime.h>
#include <hip/hip_cooperative_groups.h>
#include <cstdio>
namespace cg = cooperative_groups;

typedef unsigned short u16;
using bf16x8 = __attribute__((ext_vector_type(8))) short;
using bf16x4 = __attribute__((ext_vector_type(4))) short;
using f32x4 = __attribute__((ext_vector_type(4))) float;
using f32x16 = __attribute__((ext_vector_type(16))) float;
typedef __bf16 bfv2 __attribute__((ext_vector_type(2)));
typedef float fv2 __attribute__((ext_vector_type(2)));
#define DI __device__ __forceinline__

constexpr int NTP = 65536, NTS = 256, MTOK = 65792, DM = 1024, DINSRC = 6980, NF = 7168, DFF = 2816;
constexpr int F_KA = 512, F_VA = 1024, F_QI = 1536, F_KI = 1792, F_WI = 1856, F_QR = 1920, F_KR = 2432, F_VR = 2944,
              F_GR = 3968, F_GA = 4992, F_GRR = 6016, F_END = 7040;
constexpr long O_Y = 0, O_KP = 67371008L, O_VP = O_KP + 33554432L, O_IKP = O_VP + 33554432L, O_SP = O_IKP + 4194304L,
               O_KS = O_SP + 524288L, O_VS = O_KS + 131072L, O_IKS = O_VS + 131072L, O_SS = O_IKS + 16384L;
constexpr long OB_XB = 0, OB_VAT = 134742016L, OB_SVT = OB_VAT + 67108864L;
constexpr long W_WIN = 0;
constexpr long W_WPA = W_WIN + 14680064L;
constexpr long W_WPR = W_WPA + 1048576L;
constexpr long W_WO = W_WPR + 2097152L;
constexpr long W_WGU = W_WO + 2097152L;
constexpr long W_WDN = W_WGU + 11534336L;
constexpr long W_ROT = W_WDN + 5767168L;
constexpr long W_T5 = W_ROT + 2097152L;
constexpr long W_CTR = W_T5 + 43008L;
constexpr long R_QA = W_CTR + 256L;
constexpr long R_GR = R_QA + 67371008L;
constexpr long R_GA = R_GR + 134742016L;
constexpr long R_GRR = R_GA + 134742016L;
constexpr long R_KA = R_GRR + 134742016L;
constexpr long R_SK = R_KA + 67108864L;
constexpr long R_QI = R_SK + 34078720L;
constexpr long R_KI = R_QI + 33685504L;
constexpr long R_SKI = R_KI + 8388608L;
constexpr long R_WI = R_SKI + 4259840L;
constexpr long R_QR = R_WI + 1052672L;
constexpr long R_KR = R_QR + 67371008L;
constexpr long R_KRT = R_KR + 67371008L;
constexpr long R_SKRT = R_KRT + 67108864L;
constexpr long R_VRT = R_SKRT + 262144L;
constexpr long R_SVRT = R_VRT + 134217728L;
constexpr long R_END = R_SVRT + 524288L;
constexpr long R_MERGED = R_QR;
constexpr long R_TB = R_GR;
constexpr long R_T2B = R_QR;
constexpr long R_X1 = R_KRT;
constexpr long R_HMID = R_QA;
constexpr int T5N = 1344, T5OFF = 1277;
constexpr int LDS_BYTES = 147456;
constexpr float ALPHA = 1.189207115002721f;
constexpr float LOG2E = 1.4426950408889634f;
constexpr float QSCALE = 0.125f * LOG2E;

struct Params {
  const float *x_p, *x_s, *cache_k, *cache_v, *cache_ik, *state, *w_in, *ikg, *ikb, *t5, *gng, *w_pa, *w_pr, *w_o, *ln1g,
      *ln1b, *w_gate, *w_up, *w_down, *ln2g, *ln2b;
  float* out;
  unsigned char* ws;
  int ph_lo, ph_hi;
};

DI unsigned pack2(float a, float b) {
  fv2 v = {a, b};
  bfv2 r = __builtin_convertvector(v, bfv2);
  return __builtin_bit_cast(unsigned, r);
}
DI u16 f2bf(float a) { return (u16)(pack2(a, 0.f) & 0xffffu); }
DI float bf2f(u16 b) { return __uint_as_float(((unsigned)b) << 16); }
DI float bflo(unsigned u) { return __uint_as_float(u << 16); }
DI float bfhi(unsigned u) { return __uint_as_float(u & 0xffff0000u); }
DI uint2 pack4(float a, float b, float c, float d) { return make_uint2(pack2(a, b), pack2(c, d)); }
DI float log_gamma_h(int h) { return log1pf(-exp2f(-5.0f - (float)h)); }
DI float sigmoidf_(float x) { return 1.0f / (1.0f + __expf(-x)); }
DI float siluf_(float x) { return x / (1.0f + __expf(-x)); }
DI int crow(int r, int g) { return (r & 3) + 8 * (r >> 2) + 4 * g; }
#define MFMA32(a, b, c) __builtin_amdgcn_mfma_f32_32x32x16_bf16((a), (b), (c), 0, 0, 0)
DI bf16x8 ld16(const u16* p) { return *reinterpret_cast<const bf16x8*>(p); }
DI bf16x8 ld8x2(const u16* p0, const u16* p1) {
  bf16x4 a = *reinterpret_cast<const bf16x4*>(p0);
  bf16x4 b = *reinterpret_cast<const bf16x4*>(p1);
  bf16x8 r;
  r[0] = a[0]; r[1] = a[1]; r[2] = a[2]; r[3] = a[3]; r[4] = b[0]; r[5] = b[1]; r[6] = b[2]; r[7] = b[3];
  return r;
}
DI bf16x8 packacc8(const f32x16& x, int s) {
  unsigned p0 = pack2(x[8 * s + 0], x[8 * s + 1]), p1 = pack2(x[8 * s + 2], x[8 * s + 3]);
  unsigned p2 = pack2(x[8 * s + 4], x[8 * s + 5]), p3 = pack2(x[8 * s + 6], x[8 * s + 7]);
  uint4 u = make_uint4(p0, p1, p2, p3);
  return __builtin_bit_cast(bf16x8, u);
}

constexpr int BK = 64, HALF = 128, HT = HALF * BK;
DI int lds_byte(int r, int c) {
  int st = (r >> 4) * 2 + (c >> 5), rr = r & 15, cc = c & 31, ob = rr * 64 + cc * 2;
  return st * 1024 + (ob ^ (((ob >> 9) & 1) << 5));
}
DI void stage_rc(int b, int& R, int& C) {
  int st = b / 1024, sb = b % 1024, swz = sb ^ (((sb >> 9) & 1) << 5);
  R = (st >> 1) * 16 + swz / 64;
  C = (st & 1) * 32 + (swz % 64) / 2;
}

typedef f32x4 acc_t[2][2][4][2];

DI void gemm_core(acc_t& acc, const u16* __restrict__ A, long lda, const u16* __restrict__ Bt, long ldb, int K, int brow,
                  int bcol, u16* shm) {
#define SA(b, h) (shm + ((b)*2 + (h)) * HT)
#define SB(b, h) (shm + (4 + (b)*2 + (h)) * HT)
#define STAGE(P, BASE, LD, br, kt)                                                                            \
  do {                                                                                                        \
    long _g = (long)(br) * (LD) + (long)(kt)*BK;                                                              \
    __builtin_amdgcn_global_load_lds((const unsigned*)((BASE) + _g + (long)sr0 * (LD) + sc0),                 \
                                     (unsigned*)((char*)(P) + sb0), 16, 0, 0);                                \
    __builtin_amdgcn_global_load_lds((const unsigned*)((BASE) + _g + (long)sr1 * (LD) + sc1),                 \
                                     (unsigned*)((char*)(P) + sb0 + 8192), 16, 0, 0);                         \
  } while (0)
#define LDA(dst, b, h)                                                                                        \
  for (int m = 0; m < 4; ++m)                                                                                 \
    for (int k = 0; k < 2; ++k)                                                                               \
      dst[m][k] = *reinterpret_cast<const bf16x8*>((char*)SA(b, h) + lds_byte(wr * 64 + m * 16 + fr, k * 32 + fq * 8))
#define LDB(dst, b, h)                                                                                        \
  for (int n = 0; n < 2; ++n)                                                                                 \
    for (int k = 0; k < 2; ++k)                                                                               \
      dst[n][k] = *reinterpret_cast<const bf16x8*>((char*)SB(b, h) + lds_byte(wc * 32 + n * 16 + fr, k * 32 + fq * 8))
#define MMA(ai, bj, At_, Bt_)                                                                                 \
  do {                                                                                                        \
    __builtin_amdgcn_s_setprio(1);                                                                            \
    for (int m = 0; m < 4; ++m)                                                                               \
      for (int n = 0; n < 2; ++n)                                                                             \
        for (int k = 0; k < 2; ++k)                                                                           \
          acc[ai][bj][m][n] = __builtin_amdgcn_mfma_f32_16x16x32_bf16(At_[m][k], Bt_[n][k], acc[ai][bj][m][n], 0, 0, 0); \
    __builtin_amdgcn_s_setprio(0);                                                                            \
  } while (0)
#define WAIT_V(n) asm volatile("s_waitcnt vmcnt(" #n ")" ::: "memory")
#define WAIT_L(n) asm volatile("s_waitcnt lgkmcnt(" #n ")" ::: "memory")
#define BAR __builtin_amdgcn_s_barrier()
#define SCHED __builtin_amdgcn_sched_barrier(0)
  int tidg = threadIdx.x;
  asm volatile("" : "+v"(tidg));
  const int wid = tidg >> 6, lane = tidg & 63, wr = __builtin_amdgcn_readfirstlane(wid >> 2), wc = wid & 3, fr = lane & 15, fq = lane >> 4;
  const int sb0 = tidg * 16;
  int sr0, sc0, sr1, sc1;
  stage_rc(sb0, sr0, sc0);
  stage_rc(sb0 + 8192, sr1, sc1);
  bf16x8 At[4][2], B0[2][2], B1[2][2];
  const int nt = K / BK;
  STAGE(SB(0, 0), Bt, ldb, bcol, 0); STAGE(SA(0, 0), A, lda, brow, 0);
  STAGE(SB(0, 1), Bt, ldb, bcol + HALF, 0); STAGE(SA(0, 1), A, lda, brow + HALF, 0);
  if (wr == 1) BAR;
  WAIT_V(4); BAR;
  STAGE(SB(1, 0), Bt, ldb, bcol, 1); STAGE(SA(1, 0), A, lda, brow, 1); STAGE(SB(1, 1), Bt, ldb, bcol + HALF, 1);
  WAIT_V(6); BAR;
#pragma unroll 1
  for (int t = 0; t < nt - 2; t += 2) {
    LDB(B0, 0, 0); SCHED; LDA(At, 0, 0); STAGE(SA(1, 1), A, lda, brow + HALF, t + 1);
    WAIT_L(8); BAR; WAIT_L(0); MMA(0, 0, At, B0); BAR; SCHED;
    LDB(B1, 0, 1); STAGE(SB(0, 0), Bt, ldb, bcol, t + 2);
    BAR; WAIT_L(0); MMA(0, 1, At, B1); BAR;
    LDA(At, 0, 1); STAGE(SA(0, 0), A, lda, brow, t + 2);
    BAR; WAIT_L(0); MMA(1, 0, At, B0); BAR; SCHED;
    STAGE(SB(0, 1), Bt, ldb, bcol + HALF, t + 2);
    WAIT_V(6); BAR; MMA(1, 1, At, B1); BAR;
    LDB(B0, 1, 0); SCHED; LDA(At, 1, 0); STAGE(SA(0, 1), A, lda, brow + HALF, t + 2);
    WAIT_L(8); BAR; WAIT_L(0); MMA(0, 0, At, B0); BAR; SCHED;
    LDB(B1, 1, 1); STAGE(SB(1, 0), Bt, ldb, bcol, t + 3);
    BAR; WAIT_L(0); MMA(0, 1, At, B1); BAR;
    LDA(At, 1, 1); STAGE(SA(1, 0), A, lda, brow, t + 3);
    BAR; WAIT_L(0); MMA(1, 0, At, B0); BAR; SCHED;
    STAGE(SB(1, 1), Bt, ldb, bcol + HALF, t + 3);
    WAIT_V(6); BAR; MMA(1, 1, At, B1); BAR;
  }
  { LDB(B0, 0, 0); LDA(At, 0, 0); STAGE(SA(1, 1), A, lda, brow + HALF, nt - 1);
    BAR; WAIT_L(0); MMA(0, 0, At, B0); BAR;
    LDB(B1, 0, 1); BAR; WAIT_L(0); MMA(0, 1, At, B1); BAR;
    LDA(At, 0, 1); WAIT_V(4); BAR; WAIT_L(0); MMA(1, 0, At, B0); MMA(1, 1, At, B1); BAR; }
  { LDB(B0, 1, 0); LDA(At, 1, 0); WAIT_V(2); BAR; WAIT_L(0); MMA(0, 0, At, B0); BAR;
    LDB(B1, 1, 1); WAIT_V(0); BAR; WAIT_L(0); MMA(0, 1, At, B1); BAR;
    LDA(At, 1, 1); BAR; WAIT_L(0); MMA(1, 0, At, B0); MMA(1, 1, At, B1); BAR; }
  if (wr == 0) BAR;
#undef SA
#undef SB
#undef STAGE
#undef LDA
#undef LDB
#undef MMA
}

DI void acc_zero(acc_t& acc) {
  for (int a = 0; a < 2; ++a) for (int b = 0; b < 2; ++b) for (int m = 0; m < 4; ++m) for (int n = 0; n < 2; ++n)
    acc[a][b][m][n] = f32x4{0.f, 0.f, 0.f, 0.f};
}

DI void unit_map(int u, int nft, int fpr, int& ttile, int& ftile) {
  const int main_units = 256 * nft;
  if (u < main_units) {
    const int tpg = 256 / fpr, upg = 256 * (nft / fpr);
    int g = u / upg, r = u % upg, round = r >> 8, w = r & 255, xcd = w & 7, slot = w >> 3, tpx = tpg >> 3;
    ttile = g * tpg + xcd * tpx + (slot % tpx);
    ftile = round * fpr + slot / tpx;
  } else {
    ttile = 256;
    ftile = u - main_units;
  }
}

DI long kfrag_off(int key, int h, int d) {
  const int kb = key >> 5, kl = key & 31, ks = d >> 4, g = (d >> 3) & 1, e = d & 7;
  return ((((long)kb * 8 + h) * 4 + ks) * 64 + g * 32 + kl) * 8 + e;
}
DI long vfrag_off(int key, int h, int d) {
  const int kb = key >> 5, k5 = key & 31, sx = k5 >> 4, r = k5 & 15, g = (r >> 2) & 1, e = (r & 3) + 4 * (r >> 3);
  return ((((long)kb * 8 + h) * 4 + (sx * 2 + (d >> 5))) * 64 + g * 32 + (d & 31)) * 8 + e;
}
DI long kifrag_off(int key, int d) {
  const int kb = key >> 5, kl = key & 31, ks = d >> 4, g = (d >> 3) & 1, e = d & 7;
  return (((long)kb * 4 + ks) * 64 + g * 32 + kl) * 8 + e;
}
template <int MODE>
DI void transpose_tile(const float* __restrict__ src, const float* __restrict__ src2, long lds_, u16* __restrict__ dst,
                       long ldd, int k0, int n0, float* tile) {
  const int tid = threadIdx.x;
  __syncthreads();
  {
    int nn = tid & 63, n = (MODE == 3) ? nn : n0 + nn;
    const float* s = src;
    long col = n;
    bool ok = true;
    if (MODE == 1) {
      if (n < 1860) col = n; else if (n < F_QR) ok = false; else if (n < F_END) col = n - 60; else ok = false;
    } else if (MODE == 2) {
      int grp = n >> 6, within = n & 63;
      col = grp * 32 + (within & 31);
      s = (within < 32) ? src : src2;
    }
    for (int i = 0; i < 8; ++i) {
      int kk = (tid >> 6) + 8 * i;
      tile[kk * 65 + nn] = ok ? s[(long)(k0 + kk) * lds_ + col] : 0.f;
    }
  }
  __syncthreads();
  {
    int kk = tid & 63;
    for (int i = 0; i < 8; ++i) {
      int nn = (tid >> 6) + 8 * i;
      if (MODE == 3) dst[vfrag_off(k0 + kk, n0, nn)] = f2bf(tile[kk * 65 + nn]);
      else dst[(long)(n0 + nn) * ldd + k0 + kk] = f2bf(tile[kk * 65 + nn]);
    }
  }
}

DI void phase_prep(const Params& P, unsigned char* smem) {
  float* tile = (float*)smem;
  const int tid = threadIdx.x, nb = gridDim.x, bid = blockIdx.x;
  u16* xb = (u16*)((unsigned char*)P.out + OB_XB);
  for (long i = (long)bid * 512 + tid; i < (long)MTOK * DM / 8; i += (long)nb * 512) {
    long e = i * 8;
    const float* s = (e < (long)NTP * DM) ? (P.x_p + e) : (P.x_s + (e - (long)NTP * DM));
    const f32x4 a = __builtin_nontemporal_load((const f32x4*)s), b = __builtin_nontemporal_load((const f32x4*)(s + 4));
    uint4 o = make_uint4(pack2(a[0], a[1]), pack2(a[2], a[3]), pack2(b[0], b[1]), pack2(b[2], b[3]));
    *(uint4*)(xb + e) = o;
  }
  {
    u16* sk = (u16*)(P.ws + R_SK);
    for (long i = (long)bid * 512 + tid; i < 8L * 4096 * 512 / 8; i += (long)nb * 512) {
      long e = i * 8;
      long b = e / (4096L * 512), r = e % (4096L * 512);
      const float* s = P.cache_k + e;
      float4 a = *(const float4*)s, c = *(const float4*)(s + 4);
      *(uint4*)(sk + b * 4160L * 512 + kfrag_off((int)(r >> 9), (int)((r >> 6) & 7), (int)(r & 63))) =
          make_uint4(pack2(a.x, a.y), pack2(a.z, a.w), pack2(c.x, c.y), pack2(c.z, c.w));
    }
    u16* ski = (u16*)(P.ws + R_SKI);
    for (long i = (long)bid * 512 + tid; i < 8L * 4096 * 64 / 8; i += (long)nb * 512) {
      long e = i * 8;
      long b = e / (4096L * 64), r = e % (4096L * 64);
      const float* s = P.cache_ik + e;
      float4 a = *(const float4*)s, c = *(const float4*)(s + 4);
      *(uint4*)(ski + b * 4160L * 64 + kifrag_off((int)(r >> 6), (int)(r & 63))) =
          make_uint4(pack2(a.x, a.y), pack2(a.z, a.w), pack2(c.x, c.y), pack2(c.z, c.w));
    }
  }
  {
    float2* rot = (float2*)(P.ws + W_ROT);
    for (int i = bid * 512 + tid; i < 8192 * 32; i += nb * 512) {
      int pos = i >> 5, fi = i & 31;
      float invf = powf(10000.0f, -(float)fi / 32.0f);
      float ang = (float)pos * invf;
      double a = (double)ang;
      double kq = rint(a * 0.15915494309189535);
      float r = (float)(a - kq * 6.283185307179586);
      rot[i] = make_float2(cosf(r), sinf(r));
    }
    float* t5t = (float*)(P.ws + W_T5);
    for (int i = bid * 512 + tid; i < 8 * T5N; i += nb * 512) {
      int h = i / T5N, idx = i % T5N, rel = idx - T5OFF;
      int n = rel < 0 ? -rel : rel;
      int bucket;
      if (n < 8) bucket = n;
      else {
        int lg = 8 + (int)(logf((float)n / 8.0f) / logf(128.0f) * 8.0f);
        bucket = lg < 15 ? lg : 15;
      }
      if (rel > 0) bucket += 16;
      t5t[i] = P.t5[bucket * 8 + h] * LOG2E;
    }
    if (bid == 0 && tid < 64) ((unsigned*)(P.ws + W_CTR))[tid] = 0u;
    {
      u16* svt = (u16*)((unsigned char*)P.out + OB_SVT);
      u16* sk = (u16*)(P.ws + R_SK);
      for (int i = bid * 512 + tid; i < 8 * 16384; i += nb * 512) {
        const long o = (long)(i >> 14) * 4160 * 512 + 129L * 16384 + (i & 16383);
        svt[o] = 0; sk[o] = 0;
      }
      u16* ski = (u16*)(P.ws + R_SKI);
      for (int i = bid * 512 + tid; i < 8 * 2048; i += nb * 512) ski[(long)(i >> 11) * 4160 * 64 + 129L * 2048 + (i & 2047)] = 0;
    }
  }
  const int T_WIN = (NF / 64) * 16, T_WPA = 16 * 8, T_WPR = 256, T_WO = 256, T_WGU = 88 * 16, T_WDN = 16 * 44, T_CV = 64 * 64;
  const int total = T_WIN + T_WPA + T_WPR + T_WO + T_WGU + T_WDN + T_CV;
  for (int j = bid; j < total; j += nb) {
    int q = j;
    if (q < T_WIN) { transpose_tile<1>(P.w_in, nullptr, DINSRC, (u16*)(P.ws + W_WIN), 1024, (q & 15) * 64, (q >> 4) * 64, tile); continue; }
    q -= T_WIN;
    if (q < T_WPA) { transpose_tile<0>(P.w_pa, nullptr, 1024, (u16*)(P.ws + W_WPA), 512, (q & 7) * 64, (q >> 3) * 64, tile); continue; }
    q -= T_WPA;
    if (q < T_WPR) { transpose_tile<0>(P.w_pr, nullptr, 1024, (u16*)(P.ws + W_WPR), 1024, (q & 15) * 64, (q >> 4) * 64, tile); continue; }
    q -= T_WPR;
    if (q < T_WO) { transpose_tile<0>(P.w_o, nullptr, 1024, (u16*)(P.ws + W_WO), 1024, (q & 15) * 64, (q >> 4) * 64, tile); continue; }
    q -= T_WO;
    if (q < T_WGU) { transpose_tile<2>(P.w_gate, P.w_up, DFF, (u16*)(P.ws + W_WGU), 1024, (q & 15) * 64, (q >> 4) * 64, tile); continue; }
    q -= T_WGU;
    if (q < T_WDN) { transpose_tile<0>(P.w_down, nullptr, 1024, (u16*)(P.ws + W_WDN), DFF, (q % 44) * 64, (q / 44) * 64, tile); continue; }
    q -= T_WDN;
    {
      int bh = q >> 6, tt = q & 63, b = bh >> 3, h = bh & 7;
      transpose_tile<3>(P.cache_v + (long)b * 4096 * 512 + h * 64, nullptr, 512,
                        (u16*)((unsigned char*)P.out + OB_SVT) + (long)b * 512 * 4160, 4160, tt * 64, h, tile);
    }
  }
}

DI int launder_tid() {
  int t = threadIdx.x;
  asm volatile("" : "+v"(t));
  return t;
}
constexpr int TLD = 68;
DI uint4 pk8(f32x4 a, f32x4 b) { return make_uint4(pack2(a[0], a[1]), pack2(a[2], a[3]), pack2(b[0], b[1]), pack2(b[2], b[3])); }

DI void epi_inproj(const Params& P, acc_t& acc, int ttile, int ftile, float* T) {
  const int tid_ = launder_tid();
  const int wid = tid_ >> 6, lane = tid_ & 63, wr = wid >> 2, wc = wid & 3, fr = lane & 15, fq = lane >> 4;
  const bool samp = (ttile == 256);
  unsigned char* ws = P.ws;
  float* out = P.out;
#pragma unroll
  for (int ai = 0; ai < 2; ++ai) {
    __syncthreads();
    {
      float* Tw = T + wr * (256 * TLD);
#pragma unroll
      for (int bj = 0; bj < 2; ++bj)
#pragma unroll
        for (int m = 0; m < 4; ++m)
#pragma unroll
          for (int n = 0; n < 2; ++n)
            *(f32x4*)(Tw + (bj * 128 + wc * 32 + n * 16 + fr) * TLD + m * 16 + fq * 4) = acc[ai][bj][m][n];
    }
    __syncthreads();
    const int grp = __builtin_amdgcn_readfirstlane(tid_ >> 8), tl = tid_ & 255;
    const int fg = ftile * 256 + ai * 128 + grp * 64;
    float* Tr = T + grp * (256 * TLD) + tl * TLD;
    const int tsub = tl >> 3, pj = tl & 7;
    const float* Tgp = T + grp * (256 * TLD) + 8 * pj;
    const long token = (long)ttile * 256 + tl;
    int b, t, pos, nn, C;
    if (!samp) { b = (int)(token >> 13); t = (int)(token & 8191); pos = t; nn = t & 63; C = 64; }
    else { b = tl >> 5; t = tl & 31; pos = 4096 + t; nn = t; C = 32; }
    int ttype = 0;
    if (fg < F_KA) {
      u16* o = (u16*)(ws + R_QA) + (long)ttile * 256 * 512 + fg + 8 * pj;
#pragma unroll 2
      for (int it = 0; it < 8; ++it) {
        const int tk = it * 32 + tsub;
        f32x4 a = *(const f32x4*)(Tgp + tk * TLD), c = *(const f32x4*)(Tgp + tk * TLD + 4);
        *(uint4*)(o + (long)tk * 512) = pk8(a * QSCALE, c * QSCALE);
      }
    } else if (fg < F_VA) {
      const int c0 = fg - F_KA, hh_ = c0 >> 6;
#pragma unroll 2
      for (int it = 0; it < 8; ++it) {
        const int tk = it * 32 + tsub;
        f32x4 a = *(const f32x4*)(Tgp + tk * TLD), c = *(const f32x4*)(Tgp + tk * TLD + 4);
        float* o; u16* kb; int keyi;
        if (!samp) {
          const long tok = (long)ttile * 256 + tk;
          o = out + O_KP + tok * 512 + c0 + 8 * pj;
          kb = (u16*)(ws + R_KA) + (tok >> 13) * (8192L * 512);
          keyi = (int)(tok & 8191);
        } else {
          o = out + O_KS + (long)tk * 512 + c0 + 8 * pj;
          kb = (u16*)(ws + R_SK) + (long)(tk >> 5) * 4160 * 512;
          keyi = 4096 + (tk & 31);
        }
        __builtin_nontemporal_store(a, (f32x4*)o); __builtin_nontemporal_store(c, (f32x4*)(o + 4));
        *(uint4*)(kb + kfrag_off(keyi, hh_, 8 * pj)) = pk8(a, c);
      }
    } else if (fg < F_QI) {
      const int c0 = fg - F_VA;
      float* o = (samp ? (out + O_VS) : (out + O_VP + (long)ttile * 256 * 512)) + c0 + 8 * pj;
#pragma unroll 2
      for (int it = 0; it < 8; ++it) {
        const int tk = it * 32 + tsub;
        __builtin_nontemporal_store(*(const f32x4*)(Tgp + tk * TLD), (f32x4*)(o + (long)tk * 512));
        __builtin_nontemporal_store(*(const f32x4*)(Tgp + tk * TLD + 4), (f32x4*)(o + (long)tk * 512 + 4));
      }
      ttype = 1;
    } else if (fg < F_KI) {
      u16* o = (u16*)(ws + R_QI) + (long)ttile * 256 * 256 + (fg - F_QI) + 8 * pj;
#pragma unroll 2
      for (int it = 0; it < 8; ++it) {
        const int tk = it * 32 + tsub;
        f32x4 a = *(const f32x4*)(Tgp + tk * TLD), c = *(const f32x4*)(Tgp + tk * TLD + 4);
        *(uint4*)(o + (long)tk * 256) = pk8(a, c);
      }
    } else if (fg == F_KI) {
      float s1 = 0.f;
      for (int k = 0; k < 16; ++k) { f32x4 a = *(const f32x4*)(Tr + 4 * k); s1 += a[0] + a[1] + a[2] + a[3]; }
      const float mean = s1 * (1.0f / 64.0f);
      float s2 = 0.f;
      for (int k = 0; k < 16; ++k) {
        f32x4 a = *(const f32x4*)(Tr + 4 * k);
        for (int j = 0; j < 4; ++j) { float d = a[j] - mean; s2 += d * d; }
      }
      const float rstd = rsqrtf(s2 * (1.0f / 64.0f) + 1e-5f);
      float* o = samp ? (out + O_IKS + (long)tl * 64) : (out + O_IKP + token * 64);
      u16* kb = samp ? ((u16*)(ws + R_SKI) + (long)b * 4160 * 64) : ((u16*)(ws + R_KI) + (long)b * 8192 * 64);
      const int keyi = samp ? 4096 + t : t;
#pragma unroll 2
      for (int k = 0; k < 8; ++k) {
        f32x4 a = *(const f32x4*)(Tr + 8 * k), c = *(const f32x4*)(Tr + 8 * k + 4);
        f32x4 g0 = *(const f32x4*)(P.ikg + 8 * k), g1 = *(const f32x4*)(P.ikg + 8 * k + 4);
        f32x4 b0 = *(const f32x4*)(P.ikb + 8 * k), b1 = *(const f32x4*)(P.ikb + 8 * k + 4);
        a = (a - mean) * rstd * g0 + b0;
        c = (c - mean) * rstd * g1 + b1;
        *(f32x4*)(o + 8 * k) = a; *(f32x4*)(o + 8 * k + 4) = c;
        *(uint4*)(kb + kifrag_off(keyi, 8 * k)) = pk8(a, c);
      }
    } else if (fg == F_WI) {
      f32x4 a = *(const f32x4*)Tr;
      *(f32x4*)((float*)(ws + R_WI) + token * 4) = a * 0.0625f;
    } else if (fg < F_VR) {
      const bool isk = fg >= F_KR;
      const int h = ((isk ? fg - F_KR : fg - F_QR)) >> 6;
      const float lg = log_gamma_h(h);
      const float dec = isk ? (expf(lg * (float)(C - 1 - nn)) * 0.125f) : expf(lg * (float)(nn + 1));
      const float* rot = (const float*)(ws + W_ROT) + ((long)pos * 32) * 2;
      u16* nat = (u16*)(ws + (isk ? R_KR : R_QR)) + token * 512 + h * 64;
#pragma unroll 2
      for (int k = 0; k < 4; ++k) {
        f32x4 xa = *(const f32x4*)(Tr + 8 * k), xb = *(const f32x4*)(Tr + 8 * k + 4);
        f32x4 ya = *(const f32x4*)(Tr + 32 + 8 * k), yb = *(const f32x4*)(Tr + 32 + 8 * k + 4);
        f32x4 r0 = *(const f32x4*)(rot + 16 * k), r1 = *(const f32x4*)(rot + 16 * k + 4);
        f32x4 r2 = *(const f32x4*)(rot + 16 * k + 8), r3 = *(const f32x4*)(rot + 16 * k + 12);
        f32x4 ca = {r0[0], r0[2], r1[0], r1[2]}, sa = {r0[1], r0[3], r1[1], r1[3]};
        f32x4 cb = {r2[0], r2[2], r3[0], r3[2]}, sb = {r2[1], r2[3], r3[1], r3[3]};
        f32x4 o1a = (xa * ca - ya * sa) * dec, o1b = (xb * cb - yb * sb) * dec;
        f32x4 o2a = (xa * sa + ya * ca) * dec, o2b = (xb * sb + yb * cb) * dec;
        *(uint4*)(nat + 8 * k) = pk8(o1a, o1b);
        *(uint4*)(nat + 32 + 8 * k) = pk8(o2a, o2b);
        if (isk) {
          *(f32x4*)(Tr + 8 * k) = o1a; *(f32x4*)(Tr + 8 * k + 4) = o1b;
          *(f32x4*)(Tr + 32 + 8 * k) = o2a; *(f32x4*)(Tr + 32 + 8 * k + 4) = o2b;
        }
      }
      if (isk) ttype = 2;
    } else if (fg < F_GR) {
      ttype = 3;
    } else if (fg < F_GA) {
      u16* o = (u16*)(ws + R_GR) + (long)ttile * 256 * 1024 + (fg - F_GR) + 8 * pj;
#pragma unroll 2
      for (int it = 0; it < 8; ++it) {
        const int tk = it * 32 + tsub;
        f32x4 a = *(const f32x4*)(Tgp + tk * TLD), c = *(const f32x4*)(Tgp + tk * TLD + 4);
        for (int j = 0; j < 4; ++j) { a[j] = siluf_(a[j]); c[j] = siluf_(c[j]); }
        *(uint4*)(o + (long)tk * 1024) = pk8(a, c);
      }
    } else if (fg < F_END) {
      const bool isr = fg >= F_GRR;
      u16* o = (u16*)(ws + (isr ? R_GRR : R_GA)) + (long)ttile * 256 * 1024 + (fg - (isr ? F_GRR : F_GA)) + 8 * pj;
#pragma unroll 2
      for (int it = 0; it < 8; ++it) {
        const int tk = it * 32 + tsub;
        f32x4 a = *(const f32x4*)(Tgp + tk * TLD), c = *(const f32x4*)(Tgp + tk * TLD + 4);
        for (int j = 0; j < 4; ++j) { a[j] = sigmoidf_(a[j]); c[j] = sigmoidf_(c[j]); }
        *(uint4*)(o + (long)tk * 1024) = pk8(a, c);
      }
    }
    __syncthreads();
    if (ttype != 0) {
      const int f = tl & 63, tb = tl >> 6;
      const float* Tg = T + grp * (256 * TLD) + f;
      u16* base;
      long ldt;
      int rowi;
      if (ttype == 1) { rowi = ((fg - F_VA) >> 6) * 64 + f; ldt = samp ? 4160 : 8192;
        base = samp ? ((u16*)((unsigned char*)out + OB_SVT) + 4096) : (u16*)((unsigned char*)out + OB_VAT); }
      else if (ttype == 2) { rowi = ((fg - F_KR) >> 6) * 64 + f; ldt = samp ? 32 : 8192;
        base = samp ? (u16*)(ws + R_SKRT) : (u16*)(ws + R_KRT); }
      else { rowi = (fg - F_VR) + f; ldt = samp ? 32 : 8192;
        base = samp ? (u16*)(ws + R_SVRT) : (u16*)(ws + R_VRT); }
      const int rows_per_b = (ttype == 3) ? 1024 : 512;
#pragma unroll 2
      for (int k = 0; k < 8; ++k) {
        const int t0l = tb * 64 + k * 8;
        int bb, tt0;
        if (!samp) { bb = ttile >> 5; tt0 = (ttile & 31) * 256 + t0l; }
        else { bb = t0l >> 5; tt0 = t0l & 31; }
        float x[8];
        for (int i2 = 0; i2 < 8; ++i2) x[i2] = Tg[(t0l + i2) * TLD];
        if (ttype == 1) {
          u16* vb = samp ? ((u16*)((unsigned char*)out + OB_SVT) + (long)bb * 512 * 4160) : ((u16*)((unsigned char*)out + OB_VAT) + (long)bb * 512 * 8192);
          const int keyi = samp ? 4096 + tt0 : tt0, hh_ = (fg - F_VA) >> 6;
          *(uint2*)(vb + vfrag_off(keyi, hh_, f)) = make_uint2(pack2(x[0], x[1]), pack2(x[2], x[3]));
          *(uint2*)(vb + vfrag_off(keyi + 4, hh_, f)) = make_uint2(pack2(x[4], x[5]), pack2(x[6], x[7]));
        } else
        *(uint4*)(base + ((long)bb * rows_per_b + rowi) * ldt + tt0) =
            make_uint4(pack2(x[0], x[1]), pack2(x[2], x[3]), pack2(x[4], x[5]), pack2(x[6], x[7]));
      }
    }
  }
}

DI void phase_inproj(const Params& P, unsigned char* smem) {
  const u16* W = (const u16*)(P.ws + W_WIN);
  const u16* X = (const u16*)((unsigned char*)P.out + OB_XB);
  const int nft = NF / 256, total = 257 * nft;
  for (int u = blockIdx.x; u < total; u += gridDim.x) {
    int tt, ft;
    unit_map(u, nft, 4, tt, ft);
    acc_t acc;
    acc_zero(acc);
    __syncthreads();
    gemm_core(acc, W, 1024, X, 1024, 1024, ft * 256, tt * 256, (u16*)smem);
    epi_inproj(P, acc, tt, ft, (float*)smem);
  }
}

constexpr int L_HIST = 0, L_RES = 65536, L_ITEM = L_RES + 1024, L_WV = L_ITEM + 64, L_CL = L_WV + 256, L_U = L_CL + 8 * 4096;
constexpr int L_T5 = L_U;
constexpr int L_LIST = L_U;
constexpr int CAND_CAP = 92;
static_assert(L_LIST + 8 * 8 * CAND_CAP * 8 <= LDS_BYTES && L_T5 + 8 * T5N * 4 <= LDS_BYTES, "LDS map");
constexpr int L_SBUF = 0, L_STAT = 36864, SLD = 72;

DI unsigned mono_key(float s) {
  unsigned u = __float_as_uint(s);
  return (u & 0x80000000u) ? ~u : (u | 0x80000000u);
}

DI int score_bin(float s, float isg) {
  const float a = fabsf(s) * isg;
  const int e = (int)(__float_as_uint(a) >> 18) - ((130 << 5) - 256);
  const int ec = (e + 192) >> 2;
  int k = e >= 64 ? e : ec;
  k = k < 0 ? 0 : (k > 254 ? 254 : k);
  return (s > 0.f) ? (256 + k) : ((s < 0.f) ? (254 - k) : 255);
}

DI void attn_item(const Params& P, unsigned char* smem, bool samp, int b, int c) {
  const int tid_ = launder_tid();
  const int wid = __builtin_amdgcn_readfirstlane(tid_ >> 6), lane = tid_ & 63, l32 = lane & 31, g = lane >> 5;
  unsigned char* ws = P.ws;
  asm volatile("" : "+s"(ws));
  const int nq = samp ? 32 : 64;
  const long qrow0 = samp ? (NTP + b * 32) : ((long)b * 8192 + c * 64);
  const int nkeys = samp ? 4128 : (c + 1) * 64;
  const int ntiles = (nkeys + 63) >> 6;
  const int qpos0 = samp ? 4096 : c * 64;
  const u16* Kb = samp ? ((const u16*)(ws + R_SK) + (long)b * 4160 * 512) : ((const u16*)(ws + R_KA) + (long)b * 8192 * 512);
  const u16* VTb = samp ? ((const u16*)((unsigned char*)P.out + OB_SVT) + (long)b * 512 * 4160)
                        : ((const u16*)((unsigned char*)P.out + OB_VAT) + (long)b * 512 * 8192);
  const long ldv = samp ? 4160 : 8192;
  const u16* KIb = samp ? ((const u16*)(ws + R_SKI) + (long)b * 4160 * 64) : ((const u16*)(ws + R_KI) + (long)b * 8192 * 64);
  unsigned* hist = (unsigned*)(smem + L_HIST) + wid * 2048;
  unsigned* maskl = (unsigned*)(smem + L_HIST);
  const float* t5l = (const float*)(smem + L_T5) + wid * T5N;
  int* resl = (int*)(smem + L_RES) + wid * 32;
  unsigned* cl = (unsigned*)(smem + L_CL) + wid * 1024;
  uint2* lst = (uint2*)(smem + L_LIST) + wid * (8 * CAND_CAP);
  unsigned* ccnt = (unsigned*)(smem + L_WV) + wid * 8;

  const bool all_sel = (nkeys <= 256);
  if (all_sel) {
    for (int i = lane; i < ntiles * 16; i += 64) {
      const int kt = i >> 4, r = i & 15;
      maskl[(kt * 64 + 8 * wid + (r >> 1)) * 2 + (r & 1)] = 0xffffffffu;
    }
  } else {
    bf16x8 iq[4];
    {
      int ql = 8 * wid + (l32 >> 2);
      if (ql > nq - 1) ql = nq - 1;
      const u16* p = (const u16*)(ws + R_QI) + (qrow0 + ql) * 256 + (l32 & 3) * 64 + g * 8;
      for (int ks = 0; ks < 4; ++ks) iq[ks] = ld16(p + ks * 16);
    }
    f32x4 wv[4];
    float scl[4];
    for (int i = 0; i < 4; ++i) {
      int ql = 8 * wid + g + 2 * i;
      if (ql > nq - 1) ql = nq - 1;
      wv[i] = *(const f32x4*)((const float*)(ws + R_WI) + (qrow0 + ql) * 4);
      const float s2 = 32.0f * (wv[i][0] * wv[i][0] + wv[i][1] * wv[i][1] + wv[i][2] * wv[i][2] + wv[i][3] * wv[i][3]);
      scl[i] = rsqrtf(s2 + 1e-30f);
    }
#define RELU_(x) __builtin_amdgcn_fmed3f((x), 0.f, 3.0e38f)
#define IDX_LOAD(kt, d0, d1)                                                                     \
  {                                                                                              \
    const u16* kp = KIb + (long)(kt)*4096 + lane * 8;                                            \
    for (int ks = 0; ks < 4; ++ks) { d0[ks] = ld16(kp + ks * 512); d1[ks] = ld16(kp + 2048 + ks * 512); } \
  }
#define IDX_COMPUTE(kf0, kf1, sc)                                                                \
  {                                                                                              \
    f32x16 a0 = {}, a1 = {};                                                                     \
    for (int ks = 0; ks < 4; ++ks) { a0 = MFMA32(iq[ks], kf0[ks], a0); a1 = MFMA32(iq[ks], kf1[ks], a1); } \
    for (int i = 0; i < 4; ++i) {                                                                \
      const f32x4 w4 = wv[i];                                                                    \
      float s0 = w4[0] * RELU_(a0[4 * i]);                                                  \
      s0 = fmaf(w4[1], RELU_(a0[4 * i + 1]), s0);                                           \
      s0 = fmaf(w4[2], RELU_(a0[4 * i + 2]), s0);                                           \
      s0 = fmaf(w4[3], RELU_(a0[4 * i + 3]), s0);                                           \
      float s1 = w4[0] * RELU_(a1[4 * i]);                                                  \
      s1 = fmaf(w4[1], RELU_(a1[4 * i + 1]), s1);                                           \
      s1 = fmaf(w4[2], RELU_(a1[4 * i + 2]), s1);                                           \
      s1 = fmaf(w4[3], RELU_(a1[4 * i + 3]), s1);                                           \
      sc[i][0] = s0; sc[i][1] = s1;                                                              \
    }                                                                                            \
  }
#define IDX_SCORES(kt, sc)                                                                       \
  {                                                                                              \
    bf16x8 kf0_[4], kf1_[4];                                                                     \
    IDX_LOAD(kt, kf0_, kf1_);                                                                    \
    IDX_COMPUTE(kf0_, kf1_, sc);                                                                 \
  }
#define IDX_PIPE_BEGIN() bf16x8 nk0[4], nk1[4]; IDX_LOAD(0, nk0, nk1);
#define IDX_PIPE_STEP(kt, sc)                                                                    \
  {                                                                                              \
    f32x16 a0 = {}, a1 = {};                                                                     \
    for (int ks = 0; ks < 4; ++ks) { a0 = MFMA32(iq[ks], nk0[ks], a0); a1 = MFMA32(iq[ks], nk1[ks], a1); } \
    if ((kt) + 1 < ntiles) IDX_LOAD((kt) + 1, nk0, nk1);     \
    for (int i = 0; i < 4; ++i) {                                                                \
      const f32x4 w4 = wv[i];                                                                    \
      float s0 = w4[0] * RELU_(a0[4 * i]);                                                  \
      s0 = fmaf(w4[1], RELU_(a0[4 * i + 1]), s0);                                           \
      s0 = fmaf(w4[2], RELU_(a0[4 * i + 2]), s0);                                           \
      s0 = fmaf(w4[3], RELU_(a0[4 * i + 3]), s0);                                           \
      float s1 = w4[0] * RELU_(a1[4 * i]);                                                  \
      s1 = fmaf(w4[1], RELU_(a1[4 * i + 1]), s1);                                           \
      s1 = fmaf(w4[2], RELU_(a1[4 * i + 2]), s1);                                           \
      s1 = fmaf(w4[3], RELU_(a1[4 * i + 3]), s1);                                           \
      sc[i][0] = s0; sc[i][1] = s1;                                                              \
    }                                                                                            \
  }
    for (int i = lane; i < 2048; i += 64) hist[i] = 0u;
    { IDX_PIPE_BEGIN();
#pragma unroll 1
    for (int kt = 0; kt < ntiles; ++kt) {
      float sc[4][2];
      IDX_PIPE_STEP(kt, sc);
      if (kt * 64 + 64 <= nkeys) {
        for (int hf = 0; hf < 2; ++hf)
          for (int i = 0; i < 4; ++i) {
            const int bn = score_bin(sc[i][hf], scl[i]);
            atomicAdd(&hist[(g + 2 * i) * 256 + (bn >> 1)], 1u << (16 * (bn & 1)));
          }
      } else {
        for (int hf = 0; hf < 2; ++hf) {
          const bool valid = (kt * 64 + hf * 32 + l32) < nkeys;
          for (int i = 0; i < 4; ++i)
            if (valid) {
              const int bn = score_bin(sc[i][hf], scl[i]);
              atomicAdd(&hist[(g + 2 * i) * 256 + (bn >> 1)], 1u << (16 * (bn & 1)));
            }
        }
      }
    }
    }
    for (int q = 0; q < 8; ++q) {
      const unsigned* hq = hist + q * 256 + lane * 4;
      unsigned cnt[8];
      for (int t = 0; t < 4; ++t) { const unsigned w = hq[t]; cnt[2 * t] = w & 0xffffu; cnt[2 * t + 1] = w >> 16; }
      unsigned tot = 0;
      for (int t = 0; t < 8; ++t) tot += cnt[t];
      unsigned suf = tot;
      for (int d = 1; d < 64; d <<= 1) {
        unsigned o = __shfl_down(suf, d);
        if (lane + d < 64) suf += o;
      }
      const unsigned above = suf - tot;
      if (above < 256u && suf >= 256u) {
        unsigned a = above;
        int bin = 0, nn = 0; unsigned cb = 0; bool found = false;
        for (int t = 7; t >= 0; --t) {
          if (!found && a + cnt[t] >= 256u) { bin = t; nn = 256 - (int)a; cb = cnt[t]; found = true; }
          if (!found) a += cnt[t];
        }
        resl[q * 4] = lane * 8 + bin;
        resl[q * 4 + 1] = nn;
        resl[q * 4 + 2] = (int)cb;
      }
    }
    int bst[4], nd[4];
    bool ovf = false;
    for (int i = 0; i < 4; ++i) {
      const int q = g + 2 * i;
      bst[i] = resl[q * 4];
      nd[i] = resl[q * 4 + 1];
      ovf = ovf || (bst[i] != 255 && resl[q * 4 + 2] > CAND_CAP);
    }
    const bool wave_ovf = __ballot(ovf) != 0ull;
    unsigned klo[4], khi[4];
    {
      unsigned* thrL = (unsigned*)(smem + L_CL) + wid * 32;
      float* sclL = (float*)(thrL + 16);
      if (l32 == 0) for (int i = 0; i < 4; ++i) sclL[g + 2 * i] = scl[i];
      if (lane < 16) {
        const int q = lane >> 1, b = resl[q * 4] + (lane & 1);
        const float isg = sclL[q];
        unsigned lo = 0x007FFFFFu, hi = 0xFF800000u;
        unsigned K = 0xFFFFFFFFu;
        if (b <= 511) {
          for (int it = 0; it < 32; ++it) {
            if (lo >= hi) break;
            const unsigned mid = lo + ((hi - lo) >> 1);
            const unsigned u = (mid & 0x80000000u) ? (mid & 0x7FFFFFFFu) : ~mid;
            const int bn = score_bin(__uint_as_float(u), isg);
            if (bn >= b) hi = mid; else lo = mid + 1u;
          }
          K = hi;
        }
        thrL[lane] = K;
      }
      for (int i = 0; i < 4; ++i) { klo[i] = thrL[(g + 2 * i) * 2]; khi[i] = thrL[(g + 2 * i) * 2 + 1]; }
    }
    __syncthreads();
    if (!wave_ovf) {
      int seen[4] = {0, 0, 0, 0};
      int cbase[4] = {0, 0, 0, 0};
      const unsigned ltmask = (1u << l32) - 1u;
      const bool anyzb = __ballot(bst[0] == 255 || bst[1] == 255 || bst[2] == 255 || bst[3] == 255) != 0ull;
      IDX_PIPE_BEGIN();
#pragma unroll 1
      for (int kt = 0; kt < ntiles; ++kt) {
        float sc[4][2];
        IDX_PIPE_STEP(kt, sc);
        const bool tail = (kt * 64 + 64 > nkeys);
        unsigned mv = 0u;
        for (int hf = 0; hf < 2; ++hf) {
          const bool valid = !tail || ((kt * 64 + hf * 32 + l32) < nkeys);
          for (int i = 0; i < 4; ++i) {
            const unsigned key = mono_key(sc[i][hf]);
            bool sel = valid && (key >= khi[i]);
            const bool inb = valid && (key >= klo[i]) && (key < khi[i]);
            const bool zb = (bst[i] == 255);
            if (anyzb) {
              const unsigned long long bal = __ballot(inb && zb);
              const unsigned mym = g ? (unsigned)(bal >> 32) : (unsigned)bal;
              const int rank = __popc(mym & ltmask);
              sel = sel || (inb && zb && (seen[i] + rank < nd[i]));
              seen[i] += __popc(mym);
            }
            const bool cand = inb && !zb;
            const unsigned long long cb = __ballot(cand);
            if (cb != 0ull) {
              const unsigned mym = g ? (unsigned)(cb >> 32) : (unsigned)cb;
              const int slot = cbase[i] + __popc(mym & ltmask);
              if (cand && slot < CAND_CAP)
                lst[(g + 2 * i) * CAND_CAP + slot] = make_uint2(key, (unsigned)(kt * 64 + hf * 32 + l32));
              cbase[i] += __popc(mym);
            }
            const unsigned long long sb = __ballot(sel);
            mv = (lane == (2 * i) * 2 + hf) ? (unsigned)sb : mv;
            mv = (lane == (2 * i + 1) * 2 + hf) ? (unsigned)(sb >> 32) : mv;
          }
        }
        if (lane < 16) maskl[(kt * 64 + 8 * wid) * 2 + lane] = mv;
      }
      if (l32 == 0) for (int i = 0; i < 4; ++i) ccnt[g + 2 * i] = (unsigned)cbase[i];
      for (int q = 0; q < 8; ++q) {
        const int qb = resl[q * 4], qn = resl[q * 4 + 1];
        int n = (int)ccnt[q];
        if (n > CAND_CAP) n = CAND_CAP;
        if (qb == 255) n = 0;
        const uint2* lq = lst + q * CAND_CAP;
        const uint2 m0 = (lane < n) ? lq[lane] : make_uint2(0u, 0u);
        const uint2 m1 = (lane + 64 < n) ? lq[lane + 64] : make_uint2(0u, 0u);
        int gt0 = 0, gt1 = 0;
        for (int t = 0; t < n; ++t) {
          const uint2 o = lq[t];
          gt0 += (o.x > m0.x || (o.x == m0.x && o.y < m0.y)) ? 1 : 0;
          gt1 += (o.x > m1.x || (o.x == m1.x && o.y < m1.y)) ? 1 : 0;
        }
        if (lane < n && gt0 < qn)
          atomicOr(&maskl[((m0.y >> 6) * 64 + 8 * wid + q) * 2 + ((m0.y >> 5) & 1)], 1u << (m0.y & 31));
        if (lane + 64 < n && gt1 < qn)
          atomicOr(&maskl[((m1.y >> 6) * 64 + 8 * wid + q) * 2 + ((m1.y >> 5) & 1)], 1u << (m1.y & 31));
      }
    } else {
      unsigned tau[4] = {0u, 0u, 0u, 0u};
      int need[4] = {256, 256, 256, 256};
      for (int pass = 0; pass < 4; ++pass) {
        const int shift = 24 - 8 * pass;
        for (int i = lane; i < 1024; i += 64) cl[i] = 0u;
#pragma unroll 1
        for (int kt = 0; kt < ntiles; ++kt) {
          float sc[4][2];
          IDX_SCORES(kt, sc);
          for (int hf = 0; hf < 2; ++hf) {
            const bool valid = (kt * 64 + hf * 32 + l32) < nkeys;
            for (int i = 0; i < 4; ++i) {
              const unsigned key = mono_key(sc[i][hf]);
              const bool inb = valid && (pass == 0 || ((key >> (shift + 8)) == tau[i]));
              const unsigned dg = (key >> shift) & 255u;
              if (inb) atomicAdd(&cl[(g + 2 * i) * 128 + (dg >> 1)], 1u << (16 * (dg & 1)));
            }
          }
        }
        for (int q = 0; q < 8; ++q) {
          const int ndq = __shfl(need[q >> 1], (q & 1) * 32);
          const unsigned* hq = cl + q * 128 + lane * 2;
          const unsigned w0 = hq[0], w1 = hq[1];
          unsigned c0 = w0 & 0xffffu, c1 = w0 >> 16, c2 = w1 & 0xffffu, c3 = w1 >> 16;
          unsigned tot = c0 + c1 + c2 + c3;
          unsigned suf = tot;
          for (int d = 1; d < 64; d <<= 1) {
            unsigned o = __shfl_down(suf, d);
            if (lane + d < 64) suf += o;
          }
          const unsigned above = suf - tot;
          if (above < (unsigned)ndq && suf >= (unsigned)ndq) {
            unsigned a = above;
            int bin, nn;
            if (a + c3 >= (unsigned)ndq) { bin = 3; nn = ndq - a; }
            else { a += c3; if (a + c2 >= (unsigned)ndq) { bin = 2; nn = ndq - a; }
            else { a += c2; if (a + c1 >= (unsigned)ndq) { bin = 1; nn = ndq - a; }
            else { a += c1; bin = 0; nn = ndq - a; } } }
            resl[q * 4] = lane * 4 + bin;
            resl[q * 4 + 1] = nn;
          }
        }
        for (int i = 0; i < 4; ++i) {
          const int q = g + 2 * i;
          tau[i] = (tau[i] << 8) | (unsigned)resl[q * 4];
          need[i] = resl[q * 4 + 1];
        }
      }
      int seen[4] = {0, 0, 0, 0};
#pragma unroll 1
      for (int kt = 0; kt < ntiles; ++kt) {
        float sc[4][2];
        IDX_SCORES(kt, sc);
        for (int hf = 0; hf < 2; ++hf) {
          const bool valid = (kt * 64 + hf * 32 + l32) < nkeys;
          for (int i = 0; i < 4; ++i) {
            const unsigned key = mono_key(sc[i][hf]);
            const bool eq = valid && (key == tau[i]);
            const unsigned long long bal = __ballot(eq);
            const unsigned mym = g ? (unsigned)(bal >> 32) : (unsigned)bal;
            const int rank = __popc(mym & ((1u << l32) - 1u));
            const bool tsel = eq && (seen[i] + rank < need[i]);
            seen[i] += __popc(mym);
            const bool sel = (valid && key > tau[i]) || tsel;
            const unsigned long long sb = __ballot(sel);
            if (lane == 0) {
              maskl[(kt * 64 + 8 * wid + 2 * i) * 2 + hf] = (unsigned)sb;
              maskl[(kt * 64 + 8 * wid + 2 * i + 1) * 2 + hf] = (unsigned)(sb >> 32);
            }
          }
        }
      }
    }
#undef IDX_SCORES
#undef IDX_LOAD
#undef IDX_COMPUTE
#undef IDX_PIPE_BEGIN
#undef IDX_PIPE_STEP
  }
  __syncthreads();
  {
    const float* t5g = (const float*)(ws + W_T5);
    float* t5w = (float*)(smem + L_T5);
    for (int i = tid_; i < 8 * T5N; i += 512) t5w[i] = t5g[i] - t5g[(i / T5N) * T5N];
  }
  __syncthreads();

  const int h = wid;
  bf16x8 qf[2][4];
  for (int qh = 0; qh < 2; ++qh) {
    int ql = qh * 32 + l32;
    if (ql > nq - 1) ql = nq - 1;
    const u16* p = (const u16*)(ws + R_QA) + (qrow0 + ql) * 512 + h * 64 + g * 8;
    for (int ks = 0; ks < 4; ++ks) qf[qh][ks] = ld16(p + ks * 16);
  }
  f32x16 oacc[2][2];
  for (int a = 0; a < 2; ++a) for (int q = 0; q < 2; ++q) for (int r = 0; r < 16; ++r) oacc[a][q][r] = 0.f;
  float mrun[2] = {-1e30f, -1e30f}, lrun[2] = {0.f, 0.f};
  const u16* kbase = Kb + (long)h * 2048 + lane * 8;
  const u16* vbase = VTb + (long)h * 2048 + lane * 8;
  bf16x8 kfN[4], vfN[2][2];
  for (int ks = 0; ks < 4; ++ks) kfN[ks] = ld16(kbase + ks * 512);
  for (int dh = 0; dh < 2; ++dh)
    for (int s = 0; s < 2; ++s) vfN[dh][s] = ld16(vbase + (s * 2 + dh) * 512);
  const int nhalf = ntiles * 2;
#pragma unroll 1
  for (int hh = 0; hh < nhalf; ++hh) {
    const int kt = hh >> 1, kh = hh & 1;
    const long key0 = (long)hh * 32;
    const bool farT = (qpos0 - kt * 64) >= 1214;
    f32x16 sacc[2];
    __builtin_amdgcn_s_setprio(1);
    for (int qh = 0; qh < 2; ++qh) {
      f32x16 a = {};
      for (int ks = 0; ks < 4; ++ks) a = MFMA32(kfN[ks], qf[qh][ks], a);
      sacc[qh] = a;
    }
    __builtin_amdgcn_s_setprio(0);
    if (hh + 1 < nhalf) {
      const u16* kp = kbase + (long)(hh + 1) * 16384;
      for (int ks = 0; ks < 4; ++ks) kfN[ks] = ld16(kp + ks * 512);
    }
    for (int qh = 0; qh < 2; ++qh) {
      const int mw = (int)(maskl[(kt * 64 + qh * 32 + l32) * 2 + kh] >> (4 * g));
      const int relb = (int)key0 + 4 * g - (qpos0 + qh * 32 + l32) + T5OFF;
      float mx = -1e30f;
      if (!farT) {
        for (int r = 0; r < 16; ++r) sacc[qh][r] += t5l[relb + (r & 3) + 8 * (r >> 2)];
      }
      for (int r = 0; r < 16; ++r) {
        float l = sacc[qh][r];
        const unsigned keep = (unsigned)__builtin_amdgcn_sbfe(mw, (r & 3) + 8 * (r >> 2), 1);
        l = __uint_as_float((__float_as_uint(l) & keep) | (0xFF800000u & ~keep));
        sacc[qh][r] = l;
        mx = fmaxf(mx, l);
      }
      mx = fmaxf(mx, __shfl_xor(mx, 32));
      if (__ballot(mx > mrun[qh]) != 0ull) {
        const float mnew = fmaxf(mrun[qh], mx);
        const float alpha = __builtin_amdgcn_exp2f(mrun[qh] - mnew);
        mrun[qh] = mnew;
        lrun[qh] *= alpha;
        for (int dh = 0; dh < 2; ++dh)
          for (int r = 0; r < 16; ++r) oacc[dh][qh][r] *= alpha;
      }
      const float mcur = mrun[qh];
      float ps = 0.f;
      for (int r = 0; r < 16; ++r) {
        const float p = __builtin_amdgcn_exp2f(sacc[qh][r] - mcur);
        sacc[qh][r] = p;
        ps += p;
      }
      lrun[qh] += ps;
    }
    for (int qh = 0; qh < 2; ++qh)
      for (int s = 0; s < 2; ++s) {
        bf16x8 pf = packacc8(sacc[qh], s);
        for (int dh = 0; dh < 2; ++dh) oacc[dh][qh] = MFMA32(vfN[dh][s], pf, oacc[dh][qh]);
      }
    if (hh + 1 < nhalf) {
      const u16* vp = vbase + (long)(hh + 1) * 16384;
      for (int dh = 0; dh < 2; ++dh)
        for (int s = 0; s < 2; ++s) vfN[dh][s] = ld16(vp + (s * 2 + dh) * 512);
    }
  }
  for (int qh = 0; qh < 2; ++qh) {
    float lt = lrun[qh] + __shfl_xor(lrun[qh], 32);
    const float inv = 1.0f / lt;
    const int ql = qh * 32 + l32;
    if (ql < nq) {
      u16* ap = (u16*)(ws + R_QA) + (qrow0 + ql) * 512 + h * 64;
      for (int dh = 0; dh < 2; ++dh)
        for (int i = 0; i < 4; ++i) {
          const int d = dh * 32 + 4 * g + 8 * i;
          *(uint2*)(ap + d) = pack4(oacc[dh][qh][4 * i] * inv, oacc[dh][qh][4 * i + 1] * inv, oacc[dh][qh][4 * i + 2] * inv,
                                    oacc[dh][qh][4 * i + 3] * inv);
        }
    }
  }
}

DI void ret_item(const Params& P, unsigned char* smem, bool samp, int b, int h) {
  const int tid_ = launder_tid();
  const int wid = __builtin_amdgcn_readfirstlane(tid_ >> 6), lane = tid_ & 63, l32 = lane & 31, g = lane >> 5;
  unsigned char* ws = P.ws;
  asm volatile("" : "+s"(ws));
  const int C = samp ? 32 : 64, nchunks = samp ? 1 : 128;
  const long row0 = samp ? (NTP + b * 32) : (long)b * 8192;
  const u16* qb = (const u16*)(ws + R_QR) + row0 * 512 + h * 64;
  const u16* kb = (const u16*)(ws + R_KR) + row0 * 512 + h * 64;
  const long ldt = samp ? 32 : 8192;
  const u16* krt = samp ? ((const u16*)(ws + R_SKRT) + (long)(b * 8 + h) * 64 * 32) : ((const u16*)(ws + R_KRT) + (long)(b * 8 + h) * 64 * 8192);
  const u16* vrt = samp ? ((const u16*)(ws + R_SVRT) + (long)(b * 8 + h) * 128 * 32) : ((const u16*)(ws + R_VRT) + (long)(b * 8 + h) * 128 * 8192);
  u16* grp = (u16*)(ws + R_GR) + row0 * 1024 + h * 128;
  u16* sbuf = (u16*)(smem + L_SBUF);
  float2* stat = (float2*)(smem + L_STAT);
  const int nh = wid >> 2, eb = wid & 3;
  const int dh = nh;
  const float lg = log_gamma_h(h);
  const float gC = expf(lg * (float)C), ginvC = expf(-lg * (float)C);
  f32x16 S;
  for (int r = 0; r < 16; ++r)
    S[r] = samp ? P.state[((long)(b * 8 + h) * 64 + dh * 32 + crow(r, g)) * 128 + eb * 32 + l32] : 0.f;
  int cur = 0;
  __syncthreads();
  for (int i = 0; i < 4; ++i) {
    const int d0 = dh * 32 + 4 * g + 8 * i;
    *(uint2*)(sbuf + (eb * 32 + l32) * SLD + d0) = pack4(S[4 * i], S[4 * i + 1], S[4 * i + 2], S[4 * i + 3]);
  }
  __syncthreads();
  const bool act = !(samp && nh == 1);
#pragma unroll 1
  for (int c = 0; c < nchunks; ++c) {
    const long t0 = (long)c * 64;
    f32x16 oT = {};
    bf16x8 uaf[4], ubf[4];
    for (int ks = 0; ks < 4; ++ks)
      if (ks < C / 16) {
        uaf[ks] = ld16(krt + (long)(dh * 32 + l32) * ldt + t0 + ks * 16 + g * 8);
        ubf[ks] = ld16(vrt + (long)(eb * 32 + l32) * ldt + t0 + ks * 16 + g * 8);
      }
    uint2 sgv[4];
    if (act) {
      const u16* rp0 = grp + (t0 + nh * 32 + l32) * 1024 + eb * 32;
      for (int i = 0; i < 4; ++i) sgv[i] = *(const uint2*)(rp0 + 4 * g + 8 * i);
    }
    if (act) {
      bf16x8 qf[4];
      {
        const u16* p = qb + (t0 + nh * 32 + l32) * 512 + g * 8;
        for (int ks = 0; ks < 4; ++ks) qf[ks] = ld16(p + ks * 16);
      }
      for (int mh = 0; mh <= nh; ++mh) {
        bf16x8 kf[4];
        const u16* p = kb + (t0 + mh * 32 + l32) * 512 + g * 8;
        for (int ks = 0; ks < 4; ++ks) kf[ks] = ld16(p + ks * 16);
        f32x16 inn = {};
        for (int ks = 0; ks < 4; ++ks) inn = MFMA32(kf[ks], qf[ks], inn);
        const int ncol = nh * 32 + l32;
        for (int r = 0; r < 16; ++r) {
          const int m = mh * 32 + crow(r, g);
          inn[r] = (ncol >= m) ? inn[r] * ginvC : 0.f;
        }
        for (int s = 0; s < 2; ++s) {
          const u16* vp = vrt + (long)(eb * 32 + l32) * ldt + t0 + mh * 32 + 16 * s + 4 * g;
          bf16x8 vf = ld8x2(vp, vp + 8);
          oT = MFMA32(vf, packacc8(inn, s), oT);
        }
      }
      const u16* sp = sbuf + cur * (128 * SLD) + (eb * 32 + l32) * SLD + g * 8;
      for (int ks = 0; ks < 4; ++ks) {
        bf16x8 sf = *reinterpret_cast<const bf16x8*>(sp + ks * 16);
        oT = MFMA32(sf, qf[ks], oT);
      }
      float s1 = 0.f, s2 = 0.f;
      for (int r = 0; r < 16; ++r) { s1 += oT[r]; s2 += oT[r] * oT[r]; }
      s1 += __shfl_xor(s1, 32);
      s2 += __shfl_xor(s2, 32);
      if (g == 0) stat[(nh * 4 + eb) * 32 + l32] = make_float2(s1, s2);
    }
    __syncthreads();
    if (act) {
      float s1 = 0.f, s2 = 0.f;
      for (int e = 0; e < 4; ++e) { float2 v = stat[(nh * 4 + e) * 32 + l32]; s1 += v.x; s2 += v.y; }
      const float mean = s1 * (1.0f / 128.0f);
      const float var = fmaxf(s2 * (1.0f / 128.0f) - mean * mean, 0.f);
      const float rstd = rsqrtf(var + 1e-6f);
      u16* rp = grp + (t0 + nh * 32 + l32) * 1024 + eb * 32;
      const float* gg = P.gng + h * 128 + eb * 32;
      for (int i = 0; i < 4; ++i) {
        const int e = 4 * g + 8 * i;
        const uint2 sg = sgv[i];
        f32x4 gv = *(const f32x4*)(gg + e);
        float r0 = (oT[4 * i] - mean) * rstd * gv[0], r1 = (oT[4 * i + 1] - mean) * rstd * gv[1];
        float r2 = (oT[4 * i + 2] - mean) * rstd * gv[2], r3 = (oT[4 * i + 3] - mean) * rstd * gv[3];
        *(uint2*)(rp + e) = pack4(r0 * bflo(sg.x), r1 * bfhi(sg.x), r2 * bflo(sg.y), r3 * bfhi(sg.y));
      }
    }
    for (int r = 0; r < 16; ++r) S[r] *= gC;
    for (int ks = 0; ks < 4; ++ks)
      if (ks < C / 16) S = MFMA32(uaf[ks], ubf[ks], S);
    {
      u16* sn = sbuf + (cur ^ 1) * (128 * SLD);
      for (int i = 0; i < 4; ++i) {
        const int d0 = dh * 32 + 4 * g + 8 * i;
        *(uint2*)(sn + (eb * 32 + l32) * SLD + d0) = pack4(S[4 * i], S[4 * i + 1], S[4 * i + 2], S[4 * i + 3]);
      }
    }
    __syncthreads();
    cur ^= 1;
  }
  float* so = P.out + (samp ? O_SS : O_SP) + (long)(b * 8 + h) * 64 * 128;
  for (int r = 0; r < 16; ++r) so[(long)(dh * 32 + crow(r, g)) * 128 + eb * 32 + l32] = S[r];
}

constexpr int ITEMS_PER_Q = 8 + 1 + 128 + 8;
DI void phase_mixers(const Params& P, unsigned char* smem) {
  unsigned* ctr = (unsigned*)(P.ws + W_CTR);
  int* itl = (int*)(smem + L_ITEM);
  for (int qq = 0; qq < 8; ++qq) {
    const int b = (blockIdx.x + qq) & 7;
    for (;;) {
      __syncthreads();
      if (threadIdx.x == 0) itl[0] = (int)atomicAdd(ctr + b, 1u);
      __syncthreads();
      const int it = itl[0];
      if (it >= ITEMS_PER_Q) break;
      if (it < 8) ret_item(P, smem, false, b, it);
      else if (it >= 137) ret_item(P, smem, true, b, it - 137);
      else attn_item(P, smem, it == 8, b, it == 8 ? 0 : 127 - (it - 9));
    }
  }
}

DI void phase_merge(const Params& P, unsigned char* smem) {
  const u16* WPA = (const u16*)(P.ws + W_WPA);
  const u16* WPR = (const u16*)(P.ws + W_WPR);
  const u16* Aa = (const u16*)(P.ws + R_QA);
  const u16* Rr = (const u16*)(P.ws + R_GR);
  const u16* GA = (const u16*)(P.ws + R_GA);
  const u16* GRR = (const u16*)(P.ws + R_GRR);
  u16* MG = (u16*)(P.ws + R_MERGED);
  const int nft = 4, total = 257 * nft;
  for (int u = blockIdx.x; u < total; u += gridDim.x) {
    int tt, ft;
    unit_map(u, nft, 4, tt, ft);
    {
      acc_t acc;
      acc_zero(acc);
      __syncthreads();
      gemm_core(acc, WPA, 512, Aa, 512, 512, ft * 256, tt * 256, (u16*)smem);
      const int tid_ = launder_tid(); const int wid = tid_ >> 6, lane = tid_ & 63, wr = wid >> 2, wc = wid & 3, fr = lane & 15, fq = lane >> 4;
#pragma unroll
      for (int ai = 0; ai < 2; ++ai)
#pragma unroll
      for (int bj = 0; bj < 2; ++bj)
#pragma unroll
      for (int m = 0; m < 4; ++m)
#pragma unroll
      for (int n = 0; n < 2; ++n) {
        asm volatile("" ::: "memory");
        const long token = tt * 256 + bj * 128 + wc * 32 + n * 16 + fr;
        const int f = ft * 256 + ai * 128 + wr * 64 + m * 16 + fq * 4;
        uint2 a = *(const uint2*)(GA + token * 1024 + f);
        f32x4 v = acc[ai][bj][m][n];
        *(uint2*)(MG + token * 1024 + f) = pack4(v[0] * bflo(a.x), v[1] * bfhi(a.x), v[2] * bflo(a.y), v[3] * bfhi(a.y));
      }
    }
    {
      acc_t acc;
      acc_zero(acc);
      __syncthreads();
      gemm_core(acc, WPR, 1024, Rr, 1024, 1024, ft * 256, tt * 256, (u16*)smem);
      const int tid_ = launder_tid(); const int wid = tid_ >> 6, lane = tid_ & 63, wr = wid >> 2, wc = wid & 3, fr = lane & 15, fq = lane >> 4;
#pragma unroll
      for (int ai = 0; ai < 2; ++ai)
#pragma unroll
      for (int bj = 0; bj < 2; ++bj)
#pragma unroll
      for (int m = 0; m < 4; ++m)
#pragma unroll
      for (int n = 0; n < 2; ++n) {
        asm volatile("" ::: "memory");
        const long token = tt * 256 + bj * 128 + wc * 32 + n * 16 + fr;
        const int f = ft * 256 + ai * 128 + wr * 64 + m * 16 + fq * 4;
        uint2 r = *(const uint2*)(GRR + token * 1024 + f);
        uint2 p = *(const uint2*)(MG + token * 1024 + f);
        f32x4 v = acc[ai][bj][m][n];
        *(uint2*)(MG + token * 1024 + f) = pack4(bflo(p.x) + v[0] * bflo(r.x), bfhi(p.x) + v[1] * bfhi(r.x),
                                                 bflo(p.y) + v[2] * bflo(r.y), bfhi(p.y) + v[3] * bfhi(r.y));
      }
    }
  }
}

DI void phase_oproj(const Params& P, unsigned char* smem) {
  const u16* WO = (const u16*)(P.ws + W_WO);
  const u16* MG = (const u16*)(P.ws + R_MERGED);
  u16* TB = (u16*)(P.ws + R_TB);
  const u16* XBr = (const u16*)((unsigned char*)P.out + OB_XB);
  const int nft = 4, total = 257 * nft;
  for (int u = blockIdx.x; u < total; u += gridDim.x) {
    int tt, ft;
    unit_map(u, nft, 4, tt, ft);
    acc_t acc;
    acc_zero(acc);
    __syncthreads();
    gemm_core(acc, WO, 1024, MG, 1024, 1024, ft * 256, tt * 256, (u16*)smem);
    { const int tid_ = launder_tid(); const int wid = tid_ >> 6, lane = tid_ & 63, wr = wid >> 2, wc = wid & 3, fr = lane & 15, fq = lane >> 4;
#pragma unroll
    for (int ai = 0; ai < 2; ++ai)
#pragma unroll
    for (int bj = 0; bj < 2; ++bj)
#pragma unroll
    for (int m = 0; m < 4; ++m)
#pragma unroll
    for (int n = 0; n < 2; ++n) {
      asm volatile("" ::: "memory");
      const long token = tt * 256 + bj * 128 + wc * 32 + n * 16 + fr;
      const int f = ft * 256 + ai * 128 + wr * 64 + m * 16 + fq * 4;
      const uint2 xb2 = *(const uint2*)(XBr + token * 1024 + f);
      const f32x4 x = {bflo(xb2.x), bfhi(xb2.x), bflo(xb2.y), bfhi(xb2.y)};
      const f32x4 tv = acc[ai][bj][m][n] + x * ALPHA;
      *(uint2*)(TB + token * 1024 + f) = pack4(tv[0], tv[1], tv[2], tv[3]);
    }
    }
  }
}

template <bool TO_BF16>
DI void phase_ln(const Params& P, const float* gam, const float* bet) {
  const int wid = threadIdx.x >> 6, lane = threadIdx.x & 63;
  float* Y = P.out + O_Y;
  u16* X1 = (u16*)(P.ws + R_X1);
  const u16* SRC = (const u16*)(P.ws + (TO_BF16 ? R_TB : R_T2B));
  for (long row = (long)blockIdx.x * 8 + wid; row < MTOK; row += (long)gridDim.x * 8) {
    const u16* src = SRC + row * 1024;
    float v[16];
    float s = 0.f;
    for (int k = 0; k < 2; ++k) {
      const uint4 u = *(const uint4*)(src + k * 512 + lane * 8);
      v[8 * k + 0] = bflo(u.x); v[8 * k + 1] = bfhi(u.x); v[8 * k + 2] = bflo(u.y); v[8 * k + 3] = bfhi(u.y);
      v[8 * k + 4] = bflo(u.z); v[8 * k + 5] = bfhi(u.z); v[8 * k + 6] = bflo(u.w); v[8 * k + 7] = bfhi(u.w);
    }
    for (int e = 0; e < 16; ++e) s += v[e];
    for (int d = 1; d < 64; d <<= 1) s += __shfl_xor(s, d);
    const float mean = s * (1.0f / 1024.0f);
    float s2 = 0.f;
    for (int e = 0; e < 16; ++e) { const float d = v[e] - mean; s2 += d * d; }
    for (int d = 1; d < 64; d <<= 1) s2 += __shfl_xor(s2, d);
    const float rstd = rsqrtf(s2 * (1.0f / 1024.0f) + 1e-5f);
    for (int k = 0; k < 2; ++k) {
      const int c = k * 512 + lane * 8;
      f32x4 g0 = *(const f32x4*)(gam + c), g1 = *(const f32x4*)(gam + c + 4), b0 = *(const f32x4*)(bet + c), b1 = *(const f32x4*)(bet + c + 4), r0, r1;
      for (int j = 0; j < 4; ++j) { r0[j] = (v[8 * k + j] - mean) * rstd * g0[j] + b0[j]; r1[j] = (v[8 * k + 4 + j] - mean) * rstd * g1[j] + b1[j]; }
      if (TO_BF16) *(uint4*)(X1 + row * 1024 + c) = pk8(r0, r1);
      else { __builtin_nontemporal_store(r0, (f32x4*)(Y + row * 1024 + c)); __builtin_nontemporal_store(r1, (f32x4*)(Y + row * 1024 + c + 4)); }
    }
  }
}

DI void phase_ffn_up(const Params& P, unsigned char* smem) {
  const u16* WGU = (const u16*)(P.ws + W_WGU);
  const u16* X1 = (const u16*)(P.ws + R_X1);
  u16* HM = (u16*)(P.ws + R_HMID);
  const int nft = 22, total = 257 * nft;
  for (int u = blockIdx.x; u < total; u += gridDim.x) {
    int tt, ft;
    unit_map(u, nft, 2, tt, ft);
    acc_t acc;
    acc_zero(acc);
    __syncthreads();
    gemm_core(acc, WGU, 1024, X1, 1024, 1024, ft * 256, tt * 256, (u16*)smem);
    { const int tid_ = launder_tid(); const int wid = tid_ >> 6, lane = tid_ & 63, wr = wid >> 2, wc = wid & 3, fr = lane & 15, fq = lane >> 4;
#pragma unroll
    for (int ai = 0; ai < 2; ++ai)
#pragma unroll
    for (int bj = 0; bj < 2; ++bj)
#pragma unroll
    for (int n = 0; n < 2; ++n)
#pragma unroll
    for (int m = 0; m < 2; ++m) {
      asm volatile("" ::: "memory");
      const long token = tt * 256 + bj * 128 + wc * 32 + n * 16 + fr;
      const int jj = (ft * 4 + ai * 2 + wr) * 32 + m * 16 + fq * 4;
      f32x4 gt = acc[ai][bj][m][n], up = acc[ai][bj][m + 2][n];
      *(uint2*)(HM + token * DFF + jj) = pack4(siluf_(gt[0]) * up[0], siluf_(gt[1]) * up[1], siluf_(gt[2]) * up[2], siluf_(gt[3]) * up[3]);
    }
    }
  }
}

DI void phase_ffn_down(const Params& P, unsigned char* smem) {
  const u16* WDN = (const u16*)(P.ws + W_WDN);
  const u16* HM = (const u16*)(P.ws + R_HMID);
  const u16* X1 = (const u16*)(P.ws + R_X1);
  u16* T2B = (u16*)(P.ws + R_T2B);
  const int nft = 4, total = 257 * nft;
  for (int u = blockIdx.x; u < total; u += gridDim.x) {
    int tt, ft;
    unit_map(u, nft, 4, tt, ft);
    acc_t acc;
    acc_zero(acc);
    __syncthreads();
    gemm_core(acc, WDN, DFF, HM, DFF, DFF, ft * 256, tt * 256, (u16*)smem);
    { const int tid_ = launder_tid(); const int wid = tid_ >> 6, lane = tid_ & 63, wr = wid >> 2, wc = wid & 3, fr = lane & 15, fq = lane >> 4;
#pragma unroll
    for (int ai = 0; ai < 2; ++ai)
#pragma unroll
    for (int bj = 0; bj < 2; ++bj)
#pragma unroll
    for (int m = 0; m < 4; ++m)
#pragma unroll
    for (int n = 0; n < 2; ++n) {
      asm volatile("" ::: "memory");
      const long token = tt * 256 + bj * 128 + wc * 32 + n * 16 + fr;
      const int f = ft * 256 + ai * 128 + wr * 64 + m * 16 + fq * 4;
      uint2 x = *(const uint2*)(X1 + token * 1024 + f);
      f32x4 v = acc[ai][bj][m][n];
      v[0] += ALPHA * bflo(x.x); v[1] += ALPHA * bfhi(x.x); v[2] += ALPHA * bflo(x.y); v[3] += ALPHA * bfhi(x.y);
      *(uint2*)(T2B + token * 1024 + f) = pack4(v[0], v[1], v[2], v[3]);
    }
    }
  }
}


DI void phase_dbg(const Params& P, unsigned char* smem, long off, long rows, int cols, long ld, int slot) {
  const u16* X = (const u16*)(P.ws + off);
  unsigned long long cs = 0; unsigned nf = 0;
  for (long i = (long)blockIdx.x * 512 + threadIdx.x; i < rows * cols; i += (long)gridDim.x * 512) {
    long r = i / cols; int c = (int)(i % cols);
    u16 v = X[r * ld + c];
    cs += (unsigned long long)v * (unsigned long long)((i % 1000003) + 1);
    if ((v & 0x7f80) == 0x7f80) nf++;
  }
  unsigned long long* acc = (unsigned long long*)(P.ws + W_CTR + 64) + slot * 2;
  atomicAdd(acc, cs);
  atomicAdd(acc + 1, (unsigned long long)nf);
}

constexpr int N_PHASES = 9;
#ifndef REP_MASK
#define REP_MASK 0x0
#endif

__global__ void __launch_bounds__(512) mega(Params P) {
  extern __shared__ __attribute__((aligned(16))) unsigned char smem[];
  cg::grid_group grid = cg::this_grid();
#define RUN_PHASE(k, CALL)                                         \
  if (P.ph_lo <= (k) && (k) < P.ph_hi) {                            \
    Params Q = P;                                                   \
    asm volatile("" : "+s"(Q.ws), "+s"(Q.out));                     \
    CALL;                                                           \
    if ((REP_MASK >> (k)) & 1) { grid.sync(); CALL; }               \
    if ((k) + 1 < P.ph_hi) grid.sync();                             \
  }
  RUN_PHASE(0, phase_prep(Q, smem))
  RUN_PHASE(1, phase_inproj(Q, smem))
  RUN_PHASE(2, phase_mixers(Q, smem))
  RUN_PHASE(3, phase_merge(Q, smem))
  RUN_PHASE(4, phase_oproj(Q, smem))
  RUN_PHASE(5, phase_ln<true>(Q, Q.ln1g, Q.ln1b))
  RUN_PHASE(6, phase_ffn_up(Q, smem))
  RUN_PHASE(7, phase_ffn_down(Q, smem))
  RUN_PHASE(8, phase_ln<false>(Q, Q.ln2g, Q.ln2b))
#undef RUN_PHASE
}

#ifndef N_LAUNCH_MODE
#define N_LAUNCH_MODE 1
#endif

extern "C" void kernel_launch(void* const* d_in, const int* in_sizes, int n_in, void* d_out, int out_size, void* d_ws,
                              size_t ws_size, hipStream_t stream) {
  static int grid = 0;
  if (grid == 0) {
    int dev = 0, cus = 0, per_cu = 0;
    hipGetDevice(&dev);
    hipDeviceGetAttribute(&cus, hipDeviceAttributeMultiprocessorCount, dev);
    if (hipFuncSetAttribute((const void*)mega, hipFuncAttributeMaxDynamicSharedMemorySize, LDS_BYTES) != hipSuccess) {
      fprintf(stderr, "hipFuncSetAttribute failed\n");
    }
    hipOccupancyMaxActiveBlocksPerMultiprocessor(&per_cu, (const void*)mega, 512, LDS_BYTES);
    if (per_cu < 1) per_cu = 1;
    grid = cus * 1;
    if ((size_t)R_END > ws_size) fprintf(stderr, "workspace too small: need %ld have %zu\n", (long)R_END, ws_size);
    (void)hipGetLastError();
  }
  Params p{};
  const float** pp = (const float**)&p;
  for (int i = 0; i < 21; ++i) pp[i] = (const float*)d_in[i];
  p.out = (float*)d_out;
  p.ws = (unsigned char*)d_ws;
#if N_LAUNCH_MODE == 1
  p.ph_lo = 0; p.ph_hi = N_PHASES;
  void* args[] = {&p};
  hipError_t e = hipLaunchCooperativeKernel((const void*)mega, dim3(grid), dim3(512), args, LDS_BYTES, stream);
  if (e != hipSuccess) fprintf(stderr, "cooperative launch failed: %s (grid %d)\n", hipGetErrorString(e), grid);
#else
  for (int ph = 0; ph < N_PHASES; ++ph) {
    p.ph_lo = ph; p.ph_hi = ph + 1;
    hipLaunchKernelGGL(mega, dim3(grid), dim3(512), LDS_BYTES, stream, p);
  }
#endif
}
```
